# Optimizing an MI355X kernel written in HIP

```python
import jax
import jax.numpy as jnp
from jax import lax
import numpy as np

D_MODEL = 1024
BATCH = 8
SEQ = 2048
DEPTH = 1

CHUNK = 64
ATT_HEADS = 8
ATT_HEAD_DIM = 64
ATT_WIDTH = ATT_HEADS * ATT_HEAD_DIM
LEFT_CHUNKS = 8
BAND_CHUNKS = LEFT_CHUNKS + 1
BAND = BAND_CHUNKS * CHUNK
REL_CLIP = 64
N_REL = 2 * REL_CLIP + 1
RWKV_HEADS = 8
RWKV_HEAD_DIM = 64
RWKV_WIDTH = RWKV_HEADS * RWKV_HEAD_DIM
DECAY_LORA = 64
AAA_LORA = 64
GATE_LORA = 128
GN_EPS = 64e-5
ATT_PROJ = 3 * ATT_WIDTH
RWKV_PROJ = 3 * RWKV_WIDTH + DECAY_LORA + AAA_LORA + GATE_LORA
D_IN = ATT_PROJ + RWKV_PROJ + 2 * D_MODEL
N_GROUPS = 4
EXPERTS_PER_GROUP = 8
N_EXPERTS = N_GROUPS * EXPERTS_PER_GROUP
TOP_K = 2
D_EXPERT = 256

RMS_EPS = 1e-6

kernel_name = 'hybrid_chunk_attn_rwkv7_hier_moe'


def rmsnorm(x, g):
    xf = x.astype(jnp.float32)
    y = xf * lax.rsqrt(jnp.mean(xf * xf, axis=-1, keepdims=True) + RMS_EPS)
    return (y * g.astype(jnp.float32)).astype(x.dtype)


def token_shift(p, mu):
    prev = jnp.pad(p[:, :-1], ((0, 0), (1, 0), (0, 0)))
    return p + (prev - p) * mu


def chunk_band_attention(q, k, v, rel_table):
    bsz, seq, _ = q.shape
    nc = seq // CHUNK
    shp = (bsz, nc, CHUNK, ATT_HEADS, ATT_HEAD_DIM)
    qc = q.reshape(shp) * (ATT_HEAD_DIM ** -0.5)
    pad = ((0, 0), (LEFT_CHUNKS, 0), (0, 0), (0, 0), (0, 0))
    kp = jnp.pad(k.reshape(shp), pad)
    vp = jnp.pad(v.reshape(shp), pad)
    band_idx = jnp.arange(nc)[:, None] + jnp.arange(BAND_CHUNKS)[None, :]
    kb = kp[:, band_idx].reshape(bsz, nc, BAND, ATT_HEADS, ATT_HEAD_DIM)
    vb = vp[:, band_idx].reshape(bsz, nc, BAND, ATT_HEADS, ATT_HEAD_DIM)
    scores = jnp.einsum('bcqhd,bckhd->bhcqk', qc, kb).astype(jnp.float32)
    qpos = jnp.arange(CHUNK)
    kpos = jnp.arange(BAND)
    rel = LEFT_CHUNKS * CHUNK + qpos[:, None] - kpos[None, :]
    rel_idx = jnp.clip(rel, -REL_CLIP, REL_CLIP) + REL_CLIP
    bias = rel_table.astype(jnp.float32)[:, rel_idx]
    valid = (jnp.arange(nc)[:, None] - LEFT_CHUNKS + kpos[None, :] // CHUNK) >= 0
    scores = jnp.where(valid[None, None, :, None, :], scores + bias[None, :, None],
                       jnp.finfo(jnp.float32).min)
    probs = jax.nn.softmax(scores, axis=-1).astype(v.dtype)
    out = jnp.einsum('bhcqk,bckhd->bcqhd', probs, vb)
    return out.reshape(bsz, seq, ATT_WIDTH)


def rwkv7_step(state, inp):
    r_t, w_t, k_t, v_t, kk_t, a_t = inp
    sa = jnp.einsum('bhvk,bhk->bhv', state, -kk_t)
    state = (state * w_t[:, :, None, :]
             + sa[..., None] * (kk_t * a_t)[:, :, None, :]
             + v_t[..., None] * k_t[:, :, None, :])
    y_t = jnp.einsum('bhvk,bhk->bhv', state, r_t)
    return state, y_t


def rwkv7_time_mix(r, k, v, w_lo, a_lo, g_lo, w0, w2, a0, a2, g2, k_k, k_a, r_k, gn_g, gn_b):
    out_dtype = r.dtype
    f32 = jnp.float32
    r, k, v, w_lo, a_lo, g_lo = [t.astype(f32) for t in (r, k, v, w_lo, a_lo, g_lo)]
    bsz, seq, _ = r.shape
    log_w = -jax.nn.softplus(-(w0 + jnp.tanh(w_lo) @ w2)) - 0.5
    decay = jnp.exp(-jnp.exp(log_w))
    a = jax.nn.sigmoid(a0 + a_lo @ a2)
    g = jax.nn.sigmoid(g_lo) @ g2
    heads = lambda t: t.reshape(bsz, seq, RWKV_HEADS, RWKV_HEAD_DIM)
    kk = heads(k * k_k)
    kk = kk / jnp.maximum(jnp.sqrt(jnp.sum(kk * kk, axis=-1, keepdims=True)), 1e-12)
    k = k * (1.0 + (a - 1.0) * k_a)
    rh, wh, kh, vh, ah = [heads(t) for t in (r, decay, k, v, a)]
    xs = tuple(jnp.moveaxis(t, 1, 0) for t in (rh, wh, kh, vh, kk, ah))
    state0 = jnp.zeros((bsz, RWKV_HEADS, RWKV_HEAD_DIM, RWKV_HEAD_DIM), f32)
    _, y = lax.scan(rwkv7_step, state0, xs)
    y = jnp.moveaxis(y, 0, 1)
    mean = jnp.mean(y, axis=-1, keepdims=True)
    var = jnp.mean(jnp.square(y - mean), axis=-1, keepdims=True)
    y = ((y - mean) * lax.rsqrt(var + GN_EPS)).reshape(bsz, seq, RWKV_WIDTH) * gn_g + gn_b
    bonus = jnp.sum(rh * kh * r_k, axis=-1, keepdims=True) * vh
    y = (y + bonus.reshape(bsz, seq, RWKV_WIDTH)) * g
    return y.astype(out_dtype)


def hierarchical_moe(h, rg_w, rg_b, re_w, re_b, w_gate, w_up, w_down):
    bsz, seq, d = h.shape
    f32 = jnp.float32
    hf = h.reshape(bsz * seq, d)
    group_logits = (hf @ rg_w).astype(f32) + rg_b.astype(f32)
    group_prob = jax.nn.softmax(group_logits, axis=-1)
    g_prob, g_idx = lax.top_k(group_prob, 1)
    expert_logits = ((hf @ re_w).astype(f32) + re_b.astype(f32)).reshape(-1, N_GROUPS, EXPERTS_PER_GROUP)
    in_group = jnp.take_along_axis(expert_logits, g_idx[:, :, None], axis=1)[:, 0]
    e_logit, e_idx = lax.top_k(in_group, TOP_K)
    gate = jax.nn.softmax(e_logit, axis=-1) * g_prob
    flat_idx = g_idx * EXPERTS_PER_GROUP + e_idx
    combine = jnp.einsum('nk,nke->ne', gate, jax.nn.one_hot(flat_idx, N_EXPERTS, dtype=f32)).astype(h.dtype)
    y = jnp.zeros_like(hf)
    for grp in range(N_GROUPS):
        sl = slice(grp * EXPERTS_PER_GROUP, (grp + 1) * EXPERTS_PER_GROUP)
        hg = jnp.einsum('nd,edf->nef', hf, w_gate[sl])
        hu = jnp.einsum('nd,edf->nef', hf, w_up[sl])
        act = jax.nn.silu(hg) * hu * combine[:, sl, None]
        y = y + jnp.einsum('nef,efd->nd', act, w_down[sl])
    return y.reshape(bsz, seq, d)


def setup_inputs(seed: int = 0) -> dict:
    key = jax.random.key(seed)
    ks = jax.random.split(key, 27)
    f32 = jnp.float32
    nrm = lambda k, shape, scale: scale * jax.random.normal(k, shape, f32)
    return {
        'x': nrm(ks[0], (BATCH, SEQ, D_MODEL), 1.0),
        'ln_mix_g': 1.0 + nrm(ks[1], (DEPTH, D_MODEL), 0.02),
        'w_in': nrm(ks[2], (DEPTH, D_MODEL, D_IN), D_MODEL ** -0.5),
        'att_rel_bias': nrm(ks[3], (DEPTH, ATT_HEADS, N_REL), 0.1),
        'rwkv_mu': jax.random.uniform(ks[4], (DEPTH, RWKV_PROJ), f32),
        'rwkv_w0': jax.random.uniform(ks[5], (DEPTH, RWKV_WIDTH), f32, -6.5, -1.5),
        'rwkv_w2': nrm(ks[6], (DEPTH, DECAY_LORA, RWKV_WIDTH), 0.1 * DECAY_LORA ** -0.5),
        'rwkv_a0': nrm(ks[7], (DEPTH, RWKV_WIDTH), 0.1),
        'rwkv_a2': nrm(ks[8], (DEPTH, AAA_LORA, RWKV_WIDTH), 0.1 * AAA_LORA ** -0.5),
        'rwkv_g2': nrm(ks[9], (DEPTH, GATE_LORA, RWKV_WIDTH), GATE_LORA ** -0.5),
        'rwkv_k_k': 0.85 + nrm(ks[10], (DEPTH, RWKV_WIDTH), 0.05),
        'rwkv_k_a': 1.0 + nrm(ks[11], (DEPTH, RWKV_WIDTH), 0.05),
        'rwkv_r_k': nrm(ks[12], (DEPTH, RWKV_HEADS, RWKV_HEAD_DIM), 0.1),
        'rwkv_gn_g': 1.0 + nrm(ks[13], (DEPTH, RWKV_WIDTH), 0.02),
        'rwkv_gn_b': nrm(ks[14], (DEPTH, RWKV_WIDTH), 0.02),
        'w_branch_att': nrm(ks[15], (DEPTH, ATT_WIDTH, D_MODEL), ATT_WIDTH ** -0.5),
        'w_branch_rwkv': nrm(ks[16], (DEPTH, RWKV_WIDTH, D_MODEL), RWKV_WIDTH ** -0.5),
        'w_out': nrm(ks[17], (DEPTH, D_MODEL, D_MODEL), D_MODEL ** -0.5),
        'ln_ffn_g': 1.0 + nrm(ks[18], (DEPTH, D_MODEL), 0.02),
        'router_group_w': nrm(ks[19], (DEPTH, D_MODEL, N_GROUPS), D_MODEL ** -0.5),
        'router_group_b': nrm(ks[20], (DEPTH, N_GROUPS), 0.01),
        'router_expert_w': nrm(ks[21], (DEPTH, D_MODEL, N_EXPERTS), D_MODEL ** -0.5),
        'router_expert_b': nrm(ks[22], (DEPTH, N_EXPERTS), 0.01),
        'expert_w_gate': nrm(ks[23], (DEPTH, N_EXPERTS, D_MODEL, D_EXPERT), D_MODEL ** -0.5),
        'expert_w_up': nrm(ks[24], (DEPTH, N_EXPERTS, D_MODEL, D_EXPERT), D_MODEL ** -0.5),
        'expert_w_down': nrm(ks[25], (DEPTH, N_EXPERTS, D_EXPERT, D_MODEL), D_EXPERT ** -0.5),
        'ln_final_g': 1.0 + nrm(ks[26], (D_MODEL,), 0.02),
    }


def reference(x, ln_mix_g, w_in, att_rel_bias, rwkv_mu, rwkv_w0, rwkv_w2, rwkv_a0, rwkv_a2,
              rwkv_g2, rwkv_k_k, rwkv_k_a, rwkv_r_k, rwkv_gn_g, rwkv_gn_b, w_branch_att,
              w_branch_rwkv, w_out, ln_ffn_g, router_group_w, router_group_b, router_expert_w,
              router_expert_b, expert_w_gate, expert_w_up, expert_w_down, ln_final_g):
    W = RWKV_WIDTH
    o_w = 3 * W
    o_a = o_w + DECAY_LORA
    o_g = o_a + AAA_LORA
    for l in range(DEPTH):
        h = rmsnorm(x, ln_mix_g[l])
        proj = h @ w_in[l]
        q = proj[..., :ATT_WIDTH]
        k = proj[..., ATT_WIDTH:2 * ATT_WIDTH]
        v = proj[..., 2 * ATT_WIDTH:ATT_PROJ]
        rw = token_shift(proj[..., ATT_PROJ:ATT_PROJ + RWKV_PROJ], rwkv_mu[l])
        gates = jax.nn.sigmoid(proj[..., ATT_PROJ + RWKV_PROJ:])
        att = chunk_band_attention(q, k, v, att_rel_bias[l])
        rwkv = rwkv7_time_mix(rw[..., :W], rw[..., W:2 * W], rw[..., 2 * W:3 * W],
                              rw[..., o_w:o_a], rw[..., o_a:o_g], rw[..., o_g:],
                              rwkv_w0[l], rwkv_w2[l], rwkv_a0[l], rwkv_a2[l], rwkv_g2[l],
                              rwkv_k_k[l], rwkv_k_a[l], rwkv_r_k[l], rwkv_gn_g[l], rwkv_gn_b[l])
        merged = (gates[..., :D_MODEL] * (att @ w_branch_att[l])
                  + gates[..., D_MODEL:] * (rwkv @ w_branch_rwkv[l]))
        x = x + merged @ w_out[l]
        h = rmsnorm(x, ln_ffn_g[l])
        x = x + hierarchical_moe(h, router_group_w[l], router_group_b[l], router_expert_w[l],
                                 router_expert_b[l], expert_w_gate[l], expert_w_up[l],
                                 expert_w_down[l])
    return rmsnorm(x, ln_final_g)
```

```cpp
#include <hip/hip_runtime.h>
#include <hip/hip_bf16.h>
#include <cstdio>
#include <cstdint>

typedef unsigned short bf16_t;
typedef short bf16x8 __attribute__((ext_vector_type(8)));
typedef float f32x4 __attribute__((ext_vector_type(4)));

constexpr int BATCH = 8, SEQ = 2048, DM = 1024, M = BATCH * SEQ;
constexpr int CHUNK = 64, NCHUNK = SEQ / CHUNK, AH = 8, AD = 64, AW = 512, LEFT = 8, NREL = 129;
constexpr int RH = 8, RN = 64, RWW = 512, DLORA = 64, ALORA = 64, GLORA = 128;
constexpr int ATT_PROJ = 1536, RWKV_PROJ = 1792, D_IN = ATT_PROJ + RWKV_PROJ + 2 * DM;
constexpr int NG = 4, EPG = 8, NE = 32, DE = 256;
constexpr int MPAD = 2 * M + NE * 256;

constexpr size_t MiB = 1u << 20;
constexpr size_t WS_CTL = 0;
constexpr size_t WS_TOKE = 1 * MiB;
constexpr size_t WS_TOKP = WS_TOKE + 128 * 1024;
constexpr size_t WS_TOKG = WS_TOKP + 128 * 1024;
constexpr size_t WS_ROWTOK = WS_TOKG + 128 * 1024;
constexpr size_t WS_ROWG = WS_ROWTOK + 160 * 1024;
constexpr size_t WS_SEG = WS_ROWG + 160 * 1024;
constexpr size_t WS_XN = 20 * MiB;
constexpr size_t WS_ATTO = 20 * MiB, WS_RWKVO = 36 * MiB;
constexpr size_t WS_QKV = 52 * MiB;
constexpr size_t WS_RW = 100 * MiB;
constexpr size_t WS_MERGED = 52 * MiB;
constexpr size_t WS_H2 = 100 * MiB;
constexpr size_t WS_ACT = 204 * MiB;
constexpr size_t WS_Y0 = 20 * MiB, WS_Y1 = 52 * MiB;

__device__ __forceinline__ float bf2f(bf16_t v) { return __uint_as_float((unsigned)v << 16); }
__device__ __forceinline__ bf16_t f2bf(float f) { unsigned u = __float_as_uint(f); return (bf16_t)((u + 0x7fffu + ((u >> 16) & 1u)) >> 16); }
__device__ __forceinline__ float wave_sum(float v) {
#pragma unroll
    for (int o = 1; o < 64; o <<= 1) v += __shfl_xor(v, o);
    return v;
}
__device__ __forceinline__ float sigmoidf_(float x) { return 1.f / (1.f + expf(-x)); }

__global__ void __launch_bounds__(256) k_rmsnorm_bf16(const float* __restrict__ x, const float* __restrict__ g, bf16_t* __restrict__ out) {
    const int wave = threadIdx.x >> 6, lane = threadIdx.x & 63;
    const int row = blockIdx.x * 4 + wave;
    const f32x4* xr = (const f32x4*)(x + (size_t)row * DM) + lane;
    f32x4 v[4]; float s = 0.f;
#pragma unroll
    for (int j = 0; j < 4; ++j) { v[j] = xr[64 * j]; s += v[j].x * v[j].x + v[j].y * v[j].y + v[j].z * v[j].z + v[j].w * v[j].w; }
    const float rstd = rsqrtf(wave_sum(s) * (1.f / DM) + 1e-6f);
#pragma unroll
    for (int j = 0; j < 4; ++j) {
        const f32x4 gg = ((const f32x4*)g)[lane + 64 * j];
        bf16_t* o = out + (size_t)row * DM + 4 * (lane + 64 * j);
        o[0] = f2bf(v[j].x * rstd * gg.x); o[1] = f2bf(v[j].y * rstd * gg.y); o[2] = f2bf(v[j].z * rstd * gg.z); o[3] = f2bf(v[j].w * rstd * gg.w);
    }
}

template <int NB, class Epi>
__global__ void __launch_bounds__(256) k_gemm_simple(const bf16_t* __restrict__ A, int lda, const int* __restrict__ rowidx, int rowdiv,
                                                     const float* __restrict__ B0, const float* __restrict__ B1, int ldb, int K,
                                                     const int* __restrict__ seg, size_t bstride, Epi epi) {
    __shared__ __attribute__((aligned(16))) bf16_t sA[64][40];
    __shared__ __attribute__((aligned(16))) bf16_t sB[NB][64][40];
    const int tid = threadIdx.x, wave = tid >> 6, lane = tid & 63, fr = lane & 15, fq = lane >> 4;
    const int m0 = blockIdx.y * 64, n0 = blockIdx.x * 64;
    const float* b0 = B0; const float* b1 = B1;
    if (seg) {
        int e = 0;
        while (e < NE - 1 && m0 >= seg[e + 1]) ++e;
        if (m0 >= seg[NE]) return;
        b0 += (size_t)e * bstride; if (NB == 2) b1 += (size_t)e * bstride;
    }
    f32x4 acc[NB][2][2];
#pragma unroll
    for (int b = 0; b < NB; ++b)
#pragma unroll
        for (int i = 0; i < 2; ++i)
#pragma unroll
            for (int j = 0; j < 2; ++j) acc[b][i][j] = (f32x4){0.f, 0.f, 0.f, 0.f};
    const int ar = tid >> 2, ak = (tid & 3) * 8;
    long arow = m0 + ar;
    if (rowidx) { const int ri = rowidx[m0 + ar]; arow = ri < 0 ? -1 : ri / rowdiv; }
    const int bk = tid >> 3, bn = (tid & 7) * 8;
    for (int k0 = 0; k0 < K; k0 += 32) {
        uint4 av = make_uint4(0, 0, 0, 0);
        if (arow >= 0) av = *(const uint4*)(A + (size_t)arow * lda + k0 + ak);
        *(uint4*)&sA[ar][ak] = av;
#pragma unroll
        for (int b = 0; b < NB; ++b) {
            const float* bp = (b == 0 ? b0 : b1) + (size_t)(k0 + bk) * ldb + n0 + bn;
            const f32x4 w0 = *(const f32x4*)bp, w1 = *(const f32x4*)(bp + 4);
            sB[b][bn + 0][bk] = f2bf(w0.x); sB[b][bn + 1][bk] = f2bf(w0.y); sB[b][bn + 2][bk] = f2bf(w0.z); sB[b][bn + 3][bk] = f2bf(w0.w);
            sB[b][bn + 4][bk] = f2bf(w1.x); sB[b][bn + 5][bk] = f2bf(w1.y); sB[b][bn + 6][bk] = f2bf(w1.z); sB[b][bn + 7][bk] = f2bf(w1.w);
        }
        __syncthreads();
        const int wr = (wave >> 1) * 32, wc = (wave & 1) * 32;
        bf16x8 af[2], bfr[NB][2];
#pragma unroll
        for (int i = 0; i < 2; ++i) af[i] = *(const bf16x8*)&sA[wr + i * 16 + fr][fq * 8];
#pragma unroll
        for (int b = 0; b < NB; ++b)
#pragma unroll
            for (int j = 0; j < 2; ++j) bfr[b][j] = *(const bf16x8*)&sB[b][wc + j * 16 + fr][fq * 8];
#pragma unroll
        for (int b = 0; b < NB; ++b)
#pragma unroll
            for (int i = 0; i < 2; ++i)
#pragma unroll
                for (int j = 0; j < 2; ++j) acc[b][i][j] = __builtin_amdgcn_mfma_f32_16x16x32_bf16(af[i], bfr[b][j], acc[b][i][j], 0, 0, 0);
        __syncthreads();
    }
    const int wr = (wave >> 1) * 32, wc = (wave & 1) * 32;
#pragma unroll
    for (int i = 0; i < 2; ++i)
#pragma unroll
        for (int j = 0; j < 2; ++j)
#pragma unroll
            for (int r = 0; r < 4; ++r) {
                const int row = m0 + wr + i * 16 + fq * 4 + r, col = n0 + wc + j * 16 + fr;
                epi(row, col, acc[0][i][j][r], NB == 2 ? acc[NB - 1][i][j][r] : 0.f);
            }
}

struct EpiProj {
    bf16_t *qkv, *rw, *gates;
    __device__ void operator()(int row, int col, float v, float) const {
        if (col < ATT_PROJ) qkv[(size_t)row * ATT_PROJ + col] = f2bf(col < AW ? v * 0.125f : v);
        else if (col < ATT_PROJ + RWKV_PROJ) rw[(size_t)row * RWKV_PROJ + (col - ATT_PROJ)] = f2bf(v);
        else gates[(size_t)row * 2048 + (col - ATT_PROJ - RWKV_PROJ)] = f2bf(sigmoidf_(v));
    }
};
struct EpiMergeA {
    const bf16_t* gates; bf16_t* merged;
    __device__ void operator()(int row, int col, float v, float) const { merged[(size_t)row * DM + col] = f2bf(bf2f(gates[(size_t)row * 2048 + col]) * v); }
};
struct EpiMergeB {
    const bf16_t* gates; bf16_t* merged;
    __device__ void operator()(int row, int col, float v, float) const {
        const size_t o = (size_t)row * DM + col; merged[o] = f2bf(bf2f(merged[o]) + bf2f(gates[(size_t)row * 2048 + DM + col]) * v);
    }
};
struct EpiResid {
    const float* x; float* x1;
    __device__ void operator()(int row, int col, float v, float) const { const size_t o = (size_t)row * DM + col; x1[o] = x[o] + v; }
};
struct EpiUp {
    const float* rowg; bf16_t* act;
    __device__ void operator()(int row, int col, float hg, float hu) const { act[(size_t)row * DE + col] = f2bf(hg * sigmoidf_(hg) * hu * rowg[row]); }
};
struct EpiDown {
    const int* rowtok; bf16_t *y0, *y1;
    __device__ void operator()(int row, int col, float v, float) const {
        const int rt = rowtok[row]; if (rt < 0) return;
        bf16_t* y = (rt & 1) ? y1 : y0; y[(size_t)(rt >> 1) * DM + col] = f2bf(v);
    }
};

__global__ void __launch_bounds__(64) k_attn_naive(const bf16_t* __restrict__ qkv, const float* __restrict__ relb, bf16_t* __restrict__ out) {
    const int h = blockIdx.x & 7, c = (blockIdx.x >> 3) & 31, b = blockIdx.x >> 8, qi = threadIdx.x;
    const size_t qrow = (size_t)b * SEQ + c * CHUNK + qi;
    float q[64], o[64];
    const bf16_t* qp = qkv + qrow * ATT_PROJ + h * AD;
#pragma unroll
    for (int d = 0; d < 64; ++d) { q[d] = bf2f(qp[d]); o[d] = 0.f; }
    float mx = -INFINITY, l = 0.f;
    const int j0 = (c >= LEFT) ? 0 : (LEFT - c);
    for (int j = j0; j <= LEFT; ++j) {
        const int kc = c - LEFT + j;
        for (int kk = 0; kk < CHUNK; ++kk) {
            const size_t krow = (size_t)b * SEQ + kc * CHUNK + kk;
            const bf16_t* kp = qkv + krow * ATT_PROJ + AW + h * AD;
            const bf16_t* vp = qkv + krow * ATT_PROJ + 2 * AW + h * AD;
            float s = 0.f;
#pragma unroll
            for (int d = 0; d < 64; ++d) s += q[d] * bf2f(kp[d]);
            int rel = (c - kc) * CHUNK + qi - kk; rel = rel < -64 ? -64 : (rel > 64 ? 64 : rel);
            s += relb[h * NREL + rel + 64];
            const float mn = fmaxf(mx, s), sc = expf(mx - mn), p = expf(s - mn);
            l = l * sc + p; mx = mn;
#pragma unroll
            for (int d = 0; d < 64; ++d) o[d] = o[d] * sc + p * bf2f(vp[d]);
        }
    }
    const float inv = 1.f / l;
    bf16_t* op = out + qrow * AW + h * AD;
#pragma unroll
    for (int d = 0; d < 64; ++d) op[d] = f2bf(o[d] * inv);
}

__global__ void __launch_bounds__(64) k_rwkv_naive(const bf16_t* __restrict__ rw, const float* __restrict__ mu, const float* __restrict__ w0, const float* __restrict__ w2,
                                                   const float* __restrict__ a0, const float* __restrict__ a2, const float* __restrict__ g2, const float* __restrict__ k_k,
                                                   const float* __restrict__ k_a, const float* __restrict__ r_k, const float* __restrict__ gn_g, const float* __restrict__ gn_b,
                                                   bf16_t* __restrict__ out) {
    __shared__ float s_tw[64], s_al[64], s_sg[128], s_w[64], s_kk[64], s_kka[64], s_kp[64], s_r[64];
    const int h = blockIdx.x & 7, b = blockIdx.x >> 3, j = threadIdx.x, c = h * 64 + j;
    float st[64];
#pragma unroll
    for (int k = 0; k < 64; ++k) st[k] = 0.f;
    const float mu_r = mu[c], mu_k = mu[512 + c], mu_v = mu[1024 + c], mu_w = mu[1536 + j], mu_a = mu[1600 + j], mu_g0 = mu[1664 + j], mu_g1 = mu[1728 + j];
    const float w0c = w0[c], a0c = a0[c], kkc = k_k[c], kac = k_a[c], rkc = r_k[c], gng = gn_g[c], gnb = gn_b[c];
    float pr = 0.f, pk = 0.f, pv = 0.f, pw = 0.f, pa = 0.f, pg0 = 0.f, pg1 = 0.f;
    for (int t = 0; t < SEQ; ++t) {
        const bf16_t* p = rw + ((size_t)b * SEQ + t) * RWKV_PROJ;
        const float cr = bf2f(p[c]), ck = bf2f(p[512 + c]), cv = bf2f(p[1024 + c]), cw = bf2f(p[1536 + j]), ca = bf2f(p[1600 + j]), cg0 = bf2f(p[1664 + j]), cg1 = bf2f(p[1728 + j]);
        const float r = cr + (pr - cr) * mu_r, k = ck + (pk - ck) * mu_k, v = cv + (pv - cv) * mu_v;
        const float wl = cw + (pw - cw) * mu_w, al = ca + (pa - ca) * mu_a, gl0 = cg0 + (pg0 - cg0) * mu_g0, gl1 = cg1 + (pg1 - cg1) * mu_g1;
        pr = cr; pk = ck; pv = cv; pw = cw; pa = ca; pg0 = cg0; pg1 = cg1;
        __syncthreads();
        s_tw[j] = tanhf(wl); s_al[j] = al; s_sg[j] = sigmoidf_(gl0); s_sg[64 + j] = sigmoidf_(gl1);
        __syncthreads();
        float ws = w0c, as = a0c, g = 0.f;
        for (int i = 0; i < 64; ++i) { ws += s_tw[i] * w2[i * RWW + c]; as += s_al[i] * a2[i * RWW + c]; }
        for (int i = 0; i < 128; ++i) g += s_sg[i] * g2[i * RWW + c];
        const float xw = -ws;
        const float sp = xw > 20.f ? xw : log1pf(expf(xw));
        const float logw = -sp - 0.5f;
        const float dec = expf(-expf(logw));
        const float a = sigmoidf_(as);
        const float kkr = k * kkc;
        const float nrm = sqrtf(wave_sum(kkr * kkr));
        const float kkn = kkr / fmaxf(nrm, 1e-12f);
        const float kp = k * (1.f + (a - 1.f) * kac);
        const float bonus = wave_sum(r * kp * rkc);
        s_w[j] = dec; s_kk[j] = kkn; s_kka[j] = kkn * a; s_kp[j] = kp; s_r[j] = r;
        __syncthreads();
        float sa = 0.f;
#pragma unroll
        for (int kx = 0; kx < 64; ++kx) sa -= st[kx] * s_kk[kx];
        float y = 0.f;
#pragma unroll
        for (int kx = 0; kx < 64; ++kx) { st[kx] = st[kx] * s_w[kx] + sa * s_kka[kx] + v * s_kp[kx]; y += st[kx] * s_r[kx]; }
        const float mean = wave_sum(y) * (1.f / 64.f);
        const float dv = y - mean;
        const float var = wave_sum(dv * dv) * (1.f / 64.f);
        const float yn = dv * rsqrtf(var + 64e-5f) * gng + gnb;
        out[((size_t)b * SEQ + t) * RWW + c] = f2bf((yn + bonus * v) * g);
    }
}

__global__ void __launch_bounds__(256) k_router(const float* __restrict__ x1, const float* __restrict__ g, const float* __restrict__ wg, const float* __restrict__ bg,
                                                const float* __restrict__ we, const float* __restrict__ be, bf16_t* __restrict__ h2, int* __restrict__ tok_e, int* __restrict__ tok_p,
                                                float* __restrict__ tok_g, int* __restrict__ cnt) {
    const int wave = threadIdx.x >> 6, lane = threadIdx.x & 63;
    const int row = blockIdx.x * 4 + wave;
    const f32x4* xr = (const f32x4*)(x1 + (size_t)row * DM) + lane;
    f32x4 v[4]; float s = 0.f;
#pragma unroll
    for (int j = 0; j < 4; ++j) { v[j] = xr[64 * j]; s += v[j].x * v[j].x + v[j].y * v[j].y + v[j].z * v[j].z + v[j].w * v[j].w; }
    const float rstd = rsqrtf(wave_sum(s) * (1.f / DM) + 1e-6f);
    float lg[NG], le[NE];
#pragma unroll
    for (int e = 0; e < NG; ++e) lg[e] = 0.f;
#pragma unroll
    for (int e = 0; e < NE; ++e) le[e] = 0.f;
#pragma unroll
    for (int j = 0; j < 4; ++j) {
        const f32x4 gg = ((const f32x4*)g)[lane + 64 * j];
        float hv[4] = {v[j].x * rstd * gg.x, v[j].y * rstd * gg.y, v[j].z * rstd * gg.z, v[j].w * rstd * gg.w};
        bf16_t* o = h2 + (size_t)row * DM + 4 * (lane + 64 * j);
#pragma unroll
        for (int i = 0; i < 4; ++i) {
            o[i] = f2bf(hv[i]);
            const int k = 4 * (lane + 64 * j) + i;
            const f32x4 wgv = *(const f32x4*)(wg + (size_t)k * NG);
            lg[0] += hv[i] * wgv.x; lg[1] += hv[i] * wgv.y; lg[2] += hv[i] * wgv.z; lg[3] += hv[i] * wgv.w;
#pragma unroll
            for (int e4 = 0; e4 < NE / 4; ++e4) {
                const f32x4 wv = *(const f32x4*)(we + (size_t)k * NE + 4 * e4);
                le[4 * e4] += hv[i] * wv.x; le[4 * e4 + 1] += hv[i] * wv.y; le[4 * e4 + 2] += hv[i] * wv.z; le[4 * e4 + 3] += hv[i] * wv.w;
            }
        }
    }
#pragma unroll
    for (int e = 0; e < NG; ++e) lg[e] = wave_sum(lg[e]) + bg[e];
#pragma unroll
    for (int e = 0; e < NE; ++e) le[e] = wave_sum(le[e]) + be[e];
    if (lane == 0) {
        int gi = 0; float gm = lg[0];
#pragma unroll
        for (int e = 1; e < NG; ++e) if (lg[e] > gm) { gm = lg[e]; gi = e; }
        float gs = 0.f;
#pragma unroll
        for (int e = 0; e < NG; ++e) gs += expf(lg[e] - gm);
        const float gprob = 1.f / gs;
        float l8[EPG];
#pragma unroll
        for (int e = 0; e < EPG; ++e) {
            float t = le[e];
#pragma unroll
            for (int q = 1; q < NG; ++q) t = (gi == q) ? le[q * EPG + e] : t;
            l8[e] = t;
        }
        int i1 = 0; float m1 = l8[0];
#pragma unroll
        for (int e = 1; e < EPG; ++e) if (l8[e] > m1) { m1 = l8[e]; i1 = e; }
        int i2 = -1; float m2 = -INFINITY;
#pragma unroll
        for (int e = 0; e < EPG; ++e) if (e != i1 && l8[e] > m2) { m2 = l8[e]; i2 = e; }
        const float ex = expf(m2 - m1);
        const float p1 = 1.f / (1.f + ex), p2 = ex / (1.f + ex);
        const int e1 = gi * EPG + i1, e2 = gi * EPG + i2;
        tok_e[row * 2] = e1; tok_e[row * 2 + 1] = e2;
        tok_g[row * 2] = p1 * gprob; tok_g[row * 2 + 1] = p2 * gprob;
        tok_p[row * 2] = atomicAdd(&cnt[e1], 1); tok_p[row * 2 + 1] = atomicAdd(&cnt[e2], 1);
    }
}
__global__ void __launch_bounds__(256) k_offsets(const int* __restrict__ cnt, int* __restrict__ seg, int* __restrict__ rowtok) {
    __shared__ int s_seg[NE + 1];
    if (threadIdx.x == 0) { int a = 0; for (int e = 0; e < NE; ++e) { s_seg[e] = a; a += (cnt[e] + 255) & ~255; } s_seg[NE] = a; }
    __syncthreads();
    if (blockIdx.x == 0 && threadIdx.x <= NE) seg[threadIdx.x] = s_seg[threadIdx.x];
    for (int i = blockIdx.x * 256 + threadIdx.x; i < MPAD; i += gridDim.x * 256) rowtok[i] = -1;
}
__global__ void __launch_bounds__(256) k_scatter_idx(const int* __restrict__ tok_e, const int* __restrict__ tok_p, const float* __restrict__ tok_g, const int* __restrict__ seg,
                                                     int* __restrict__ rowtok, float* __restrict__ rowg) {
    const int i = blockIdx.x * 256 + threadIdx.x;
    if (i >= 2 * M) return;
    const int row = seg[tok_e[i]] + tok_p[i];
    rowtok[row] = i; rowg[row] = tok_g[i];
}
__global__ void __launch_bounds__(256) k_final(const float* x1, const bf16_t* __restrict__ y0, const bf16_t* __restrict__ y1, const float* __restrict__ g, float* out) {
    const int wave = threadIdx.x >> 6, lane = threadIdx.x & 63;
    const int row = blockIdx.x * 4 + wave;
    const f32x4* xr = (const f32x4*)(x1 + (size_t)row * DM) + lane;
    f32x4 v[4]; float s = 0.f;
#pragma unroll
    for (int j = 0; j < 4; ++j) {
        v[j] = xr[64 * j];
        const bf16_t* a = y0 + (size_t)row * DM + 4 * (lane + 64 * j); const bf16_t* bq = y1 + (size_t)row * DM + 4 * (lane + 64 * j);
        v[j].x += bf2f(a[0]) + bf2f(bq[0]); v[j].y += bf2f(a[1]) + bf2f(bq[1]); v[j].z += bf2f(a[2]) + bf2f(bq[2]); v[j].w += bf2f(a[3]) + bf2f(bq[3]);
        s += v[j].x * v[j].x + v[j].y * v[j].y + v[j].z * v[j].z + v[j].w * v[j].w;
    }
    const float rstd = rsqrtf(wave_sum(s) * (1.f / DM) + 1e-6f);
#pragma unroll
    for (int j = 0; j < 4; ++j) {
        const f32x4 gg = ((const f32x4*)g)[lane + 64 * j];
        f32x4 o = {v[j].x * rstd * gg.x, v[j].y * rstd * gg.y, v[j].z * rstd * gg.z, v[j].w * rstd * gg.w};
        ((f32x4*)(out + (size_t)row * DM))[lane + 64 * j] = o;
    }
}

extern "C" void kernel_launch(void* const* d_in, const int* in_sizes, int n_in, void* d_out, int out_size, void* d_ws, size_t ws_size, hipStream_t stream) {
    const float* x = (const float*)d_in[0]; const float* ln_mix_g = (const float*)d_in[1]; const float* w_in = (const float*)d_in[2]; const float* relb = (const float*)d_in[3];
    const float* mu = (const float*)d_in[4]; const float* w0 = (const float*)d_in[5]; const float* w2 = (const float*)d_in[6]; const float* a0 = (const float*)d_in[7];
    const float* a2 = (const float*)d_in[8]; const float* g2 = (const float*)d_in[9]; const float* k_k = (const float*)d_in[10]; const float* k_a = (const float*)d_in[11];
    const float* r_k = (const float*)d_in[12]; const float* gn_g = (const float*)d_in[13]; const float* gn_b = (const float*)d_in[14]; const float* wba = (const float*)d_in[15];
    const float* wbr = (const float*)d_in[16]; const float* w_out = (const float*)d_in[17]; const float* ln_ffn_g = (const float*)d_in[18]; const float* rgw = (const float*)d_in[19];
    const float* rgb = (const float*)d_in[20]; const float* rew = (const float*)d_in[21]; const float* reb = (const float*)d_in[22]; const float* ewg = (const float*)d_in[23];
    const float* ewu = (const float*)d_in[24]; const float* ewd = (const float*)d_in[25]; const float* ln_final_g = (const float*)d_in[26];
    unsigned char* ws = (unsigned char*)d_ws;
    if (ws_size < 256 * MiB) { fprintf(stderr, "ws too small: %zu\n", ws_size); return; }
    int* cnt = (int*)(ws + WS_CTL);
    int* tok_e = (int*)(ws + WS_TOKE); int* tok_p = (int*)(ws + WS_TOKP); float* tok_g = (float*)(ws + WS_TOKG);
    int* rowtok = (int*)(ws + WS_ROWTOK); float* rowg = (float*)(ws + WS_ROWG); int* seg = (int*)(ws + WS_SEG);
    bf16_t* XN = (bf16_t*)(ws + WS_XN); bf16_t* ATTO = (bf16_t*)(ws + WS_ATTO); bf16_t* RWKVO = (bf16_t*)(ws + WS_RWKVO);
    bf16_t* QKV = (bf16_t*)(ws + WS_QKV); bf16_t* RW = (bf16_t*)(ws + WS_RW); bf16_t* MERGED = (bf16_t*)(ws + WS_MERGED); bf16_t* H2 = (bf16_t*)(ws + WS_H2);
    bf16_t* ACT = (bf16_t*)(ws + WS_ACT); bf16_t* Y0 = (bf16_t*)(ws + WS_Y0); bf16_t* Y1 = (bf16_t*)(ws + WS_Y1);
    bf16_t* GATES = (bf16_t*)d_out; float* X1 = (float*)d_out; float* OUT = (float*)d_out;

    hipMemsetAsync(ws + WS_CTL, 0, 4096, stream);
    k_rmsnorm_bf16<<<M / 4, 256, 0, stream>>>(x, ln_mix_g, XN);
    k_gemm_simple<1, EpiProj><<<dim3(D_IN / 64, M / 64), 256, 0, stream>>>(XN, DM, nullptr, 1, w_in, nullptr, D_IN, DM, nullptr, 0, EpiProj{QKV, RW, GATES});
    k_attn_naive<<<BATCH * NCHUNK * AH, 64, 0, stream>>>(QKV, relb, ATTO);
    k_rwkv_naive<<<BATCH * RH, 64, 0, stream>>>(RW, mu, w0, w2, a0, a2, g2, k_k, k_a, r_k, gn_g, gn_b, RWKVO);
    k_gemm_simple<1, EpiMergeA><<<dim3(DM / 64, M / 64), 256, 0, stream>>>(ATTO, AW, nullptr, 1, wba, nullptr, DM, AW, nullptr, 0, EpiMergeA{GATES, MERGED});
    k_gemm_simple<1, EpiMergeB><<<dim3(DM / 64, M / 64), 256, 0, stream>>>(RWKVO, RWW, nullptr, 1, wbr, nullptr, DM, RWW, nullptr, 0, EpiMergeB{GATES, MERGED});
    k_gemm_simple<1, EpiResid><<<dim3(DM / 64, M / 64), 256, 0, stream>>>(MERGED, DM, nullptr, 1, w_out, nullptr, DM, DM, nullptr, 0, EpiResid{x, X1});
    k_router<<<M / 4, 256, 0, stream>>>(X1, ln_ffn_g, rgw, rgb, rew, reb, H2, tok_e, tok_p, tok_g, cnt);
    k_offsets<<<64, 256, 0, stream>>>(cnt, seg, rowtok);
    k_scatter_idx<<<2 * M / 256, 256, 0, stream>>>(tok_e, tok_p, tok_g, seg, rowtok, rowg);
    k_gemm_simple<2, EpiUp><<<dim3(DE / 64, MPAD / 64), 256, 0, stream>>>(H2, DM, rowtok, 2, ewg, ewu, DE, DM, seg, (size_t)DM * DE, EpiUp{rowg, ACT});
    k_gemm_simple<1, EpiDown><<<dim3(DM / 64, MPAD / 64), 256, 0, stream>>>(ACT, DE, nullptr, 1, ewd, nullptr, DM, DE, seg, (size_t)DE * DM, EpiDown{rowtok, Y0, Y1});
    k_final<<<M / 4, 256, 0, stream>>>(X1, Y0, Y1, ln_final_g, OUT);
}
```

```cpp
#include <hip/hip_runtime.h>
#include <hip/hip_bf16.h>
#include <cstdio>
#include <cstdint>

constexpr int BATCH = 8, SEQ = 2048, DM = 1024, M = BATCH * SEQ;
constexpr int CHUNK = 64, NCHUNK = SEQ / CHUNK, AH = 8, AD = 64, AW = 512, LEFT = 8, NREL = 129;
constexpr int RH = 8, RN = 64, RWW = 512, DLORA = 64, ALORA = 64, GLORA = 128;
constexpr int ATT_PROJ = 1536, RWKV_PROJ = 1792, D_IN = ATT_PROJ + RWKV_PROJ + 2 * DM;
constexpr int NG = 4, EPG = 8, NE = 32, DE = 256;
constexpr int MPAD = 2 * M + NE * 256;

constexpr size_t MiB = 1u << 20;
constexpr size_t WS_CTL = 0;
constexpr size_t CTL_ZERO_BYTES = 1 * MiB;
constexpr size_t WS_ELIST = 1 * MiB;
constexpr size_t WS_EGATE = 3 * MiB;
constexpr size_t WS_WIN = 5 * MiB;
constexpr size_t WS_W2T = 15 * MiB + 512 * 1024;
constexpr size_t WS_A2T = WS_W2T + 65536, WS_G2T = WS_W2T + 131072;
constexpr size_t WS_WBR2 = 16 * MiB;
constexpr size_t WS_WOUT = 18 * MiB;
constexpr size_t WS_XN = 20 * MiB;
constexpr size_t WS_BR = 20 * MiB;
constexpr size_t WS_QKV = 52 * MiB;
constexpr size_t WS_RW = 100 * MiB;
constexpr size_t WS_TT = 100 * MiB;
constexpr size_t WS_F = 156 * MiB;
constexpr size_t WS_MERGED = 52 * MiB;
constexpr size_t WS_H2 = 84 * MiB;
constexpr size_t WS_WUP = 116 * MiB;
constexpr size_t WS_WDN = 148 * MiB;
constexpr size_t WS_ACT = 164 * MiB;
constexpr size_t WS_Y0 = 184 * MiB, WS_Y1 = 216 * MiB;
constexpr int CW_CNT = 0;
constexpr int CW_BAR = 4096;

namespace pg8 {
#define PG8_LAS __attribute__((address_space(3)))
typedef unsigned short bf16_t;
typedef short bf16x8 __attribute__((ext_vector_type(8)));
typedef float f32x4 __attribute__((ext_vector_type(4)));
typedef unsigned u32x4 __attribute__((ext_vector_type(4)));
constexpr int BM = 256, BK = 64, HALF = 128, HTB = HALF * BK * 2  , STAGE_BYTES = 8 * HTB, NXCD = 8, WGM = 8;

__host__ __device__ __forceinline__ int lds_byte(int r, int c) { const int st = (r >> 4) * 2 + (c >> 5), rr = r & 15, cc = c & 31, ob = rr * 64 + cc * 2; return st * 1024 + (ob ^ (((ob >> 9) & 1) << 5)); }
__host__ __device__ __forceinline__ void stage_rc(int b, int& R, int& C) { const int st = b / 1024, sb = b % 1024, swz = sb ^ (((sb >> 9) & 1) << 5); R = (st >> 1) * 16 + swz / 64; C = (st & 1) * 32 + (swz % 64) / 2; }
__host__ __device__ __forceinline__ int perm32(int rho) { const int n = rho >> 4, i = rho & 15; return 8 * (i >> 2) + 4 * n + (i & 3); }

struct Unit { int pm, pn, pb, e, r0; };
struct Gemm { const bf16_t* A; const bf16_t* Bt; int M, N, K; const int* rowidx; const int* cnt; };

struct StaticOrder {
    int nM, nN, nwg, G, c;
    __host__ __device__ void init(int M, int N, int G_, int c_) { nM = M / BM; nN = N / BM; nwg = nM * nN; G = G_; c = c_; }
    __host__ __device__ bool next(int i, Unit& u) const {
        const long L = (long)i * G + c; if (L >= nwg) return false;
        int wgid = (int)L; { const int q = nwg / NXCD, r = nwg % NXCD, xcd = wgid % NXCD, off = wgid / NXCD; wgid = (xcd < r ? xcd * (q + 1) : r * (q + 1) + (xcd - r) * q) + off; }
        const int nig = WGM * nN, gid = wgid / nig, fm = gid * WGM, gsz = (nM - fm) < WGM ? (nM - fm) : WGM;
        u.pm = fm + ((wgid % nig) % gsz); u.pn = (wgid % nig) / gsz; u.pb = u.pn; u.e = 0; u.r0 = 0; return true;
    }
    __device__ __forceinline__ void a_ready(const Unit&) const {}
    __device__ __forceinline__ void done(const Unit&) const {}
};
struct GroupOrder {
    const PG8_LAS int* seg; int nN, G, c;
    __device__ __forceinline__ bool next(int i, Unit& u) const {
        const int L = i * G + c; const int mt = L / nN; if (mt * BM >= seg[32]) return false;
        int e = 0;
#pragma unroll 1
        while (e < 31 && mt * BM >= seg[e + 1]) ++e;
        u.pm = mt; u.pn = L % nN; u.pb = e * nN + u.pn; u.e = e; u.r0 = mt * BM - seg[e]; return true;
    }
    __device__ __forceinline__ void a_ready(const Unit&) const {}
    __device__ __forceinline__ void done(const Unit&) const {}
};
constexpr int ECAP = 16384;

__device__ __forceinline__ unsigned cvt_pk_bf16(float lo, float hi) { unsigned r; asm volatile("v_cvt_pk_bf16_f32 %0, %1, %2" : "=v"(r) : "v"(lo), "v"(hi)); return r; }
__device__ __forceinline__ float bflo(unsigned w) { return __uint_as_float(w << 16); }
__device__ __forceinline__ float bfhi(unsigned w) { return __uint_as_float(w & 0xffff0000u); }
__device__ __forceinline__ float fsigmoid(float x) { return __builtin_amdgcn_rcpf(1.f + __expf(-x)); }

__device__ __forceinline__ void gather_offs(const Gemm& g, const Unit& u, int tid, unsigned (&o0)[2], unsigned (&o1)[2]) {
    const int ce = g.cnt[u.e]; const int* el = g.rowidx + u.e * ECAP + u.r0;
#pragma unroll
    for (int i = 0; i < 2; ++i) { int R, C; stage_rc(tid * 16 + i * 8192, R, C);
        const int r0 = (u.r0 + R < ce) ? el[R] : 0, r1 = (u.r0 + HALF + R < ce) ? el[HALF + R] : 0;
        o0[i] = (unsigned)((r0 >> 1) * g.K + C) * 2u; o1[i] = (unsigned)((r1 >> 1) * g.K + C) * 2u; }
}

struct EpiProj {
    static constexpr bool PERM = true, AFTER_DRAIN = false, HAS_MID = false;
    bf16_t *qkv, *rw, *gates;
    __device__ __forceinline__ void operator()(const f32x4 (&acc)[2][2][4][2], const Unit& u, int wr, int wc, int fr, int fq) const {
        const int row0 = u.pm * BM + wr * 64 + fr;
        bf16_t* base; int ld, c0, mode;
        if (u.pn < 6) { base = qkv; ld = ATT_PROJ; c0 = u.pn * BM; mode = u.pn < 2 ? 1 : 0; }
        else if (u.pn < 13) { base = rw; ld = RWKV_PROJ; c0 = (u.pn - 6) * BM; mode = 0; }
        else { base = gates; ld = 2048; c0 = (u.pn - 13) * BM; mode = 2; }
        const int col0 = c0 + wc * 32 + 8 * fq;
#pragma unroll
        for (int ai = 0; ai < 2; ++ai)
#pragma unroll
            for (int m = 0; m < 4; ++m) { bf16_t* rowp = base + (size_t)(row0 + ai * HALF + m * 16) * ld + col0;
#pragma unroll
                for (int bj = 0; bj < 2; ++bj) { f32x4 v0 = acc[ai][bj][m][0], v1 = acc[ai][bj][m][1];
                    if (mode == 1) { v0 = v0 * 0.125f; v1 = v1 * 0.125f; }
                    if (mode == 2) {
#pragma unroll
                        for (int q = 0; q < 4; ++q) { v0[q] = fsigmoid(v0[q]); v1[q] = fsigmoid(v1[q]); } }
                    u32x4 w; w.x = cvt_pk_bf16(v0[0], v0[1]); w.y = cvt_pk_bf16(v0[2], v0[3]); w.z = cvt_pk_bf16(v1[0], v1[1]); w.w = cvt_pk_bf16(v1[2], v1[3]);
                    *(u32x4*)(rowp + bj * HALF) = w; } }
    }
};

struct EpiMerge {
    static constexpr bool PERM = true, AFTER_DRAIN = false, HAS_MID = true;
    const bf16_t* gates; bf16_t* merged;
    __device__ __forceinline__ void mid(f32x4 (&acc)[2][2][4][2], const Unit& u, int wr, int wc, int fr, int fq) const {
        const int row0 = u.pm * BM + wr * 64 + fr, col0 = u.pn * BM + wc * 32 + 8 * fq;
#pragma unroll
        for (int ai = 0; ai < 2; ++ai)
#pragma unroll
            for (int m = 0; m < 4; ++m) { const bf16_t* gp = gates + (size_t)(row0 + ai * HALF + m * 16) * 2048 + col0;
#pragma unroll
                for (int bj = 0; bj < 2; ++bj) { const u32x4 ga = *(const u32x4*)(gp + bj * HALF), gb = *(const u32x4*)(gp + DM + bj * HALF);
                    f32x4 r0, r1;
                    r0[0] = bflo(ga.x) * __builtin_amdgcn_rcpf(bflo(gb.x)); r0[1] = bfhi(ga.x) * __builtin_amdgcn_rcpf(bfhi(gb.x));
                    r0[2] = bflo(ga.y) * __builtin_amdgcn_rcpf(bflo(gb.y)); r0[3] = bfhi(ga.y) * __builtin_amdgcn_rcpf(bfhi(gb.y));
                    r1[0] = bflo(ga.z) * __builtin_amdgcn_rcpf(bflo(gb.z)); r1[1] = bfhi(ga.z) * __builtin_amdgcn_rcpf(bfhi(gb.z));
                    r1[2] = bflo(ga.w) * __builtin_amdgcn_rcpf(bflo(gb.w)); r1[3] = bfhi(ga.w) * __builtin_amdgcn_rcpf(bfhi(gb.w));
                    acc[ai][bj][m][0] = acc[ai][bj][m][0] * r0; acc[ai][bj][m][1] = acc[ai][bj][m][1] * r1; } }
    }
    __device__ __forceinline__ void operator()(const f32x4 (&acc)[2][2][4][2], const Unit& u, int wr, int wc, int fr, int fq) const {
        const int row0 = u.pm * BM + wr * 64 + fr, col0 = u.pn * BM + wc * 32 + 8 * fq;
#pragma unroll
        for (int ai = 0; ai < 2; ++ai)
#pragma unroll
            for (int m = 0; m < 4; ++m) { const size_t ro = (size_t)(row0 + ai * HALF + m * 16);
#pragma unroll
                for (int bj = 0; bj < 2; ++bj) { const u32x4 gb = *(const u32x4*)(gates + ro * 2048 + DM + col0 + bj * HALF);
                    const f32x4 v0 = acc[ai][bj][m][0], v1 = acc[ai][bj][m][1];
                    u32x4 w; w.x = cvt_pk_bf16(v0[0] * bflo(gb.x), v0[1] * bfhi(gb.x)); w.y = cvt_pk_bf16(v0[2] * bflo(gb.y), v0[3] * bfhi(gb.y));
                    w.z = cvt_pk_bf16(v1[0] * bflo(gb.z), v1[1] * bfhi(gb.z)); w.w = cvt_pk_bf16(v1[2] * bflo(gb.w), v1[3] * bfhi(gb.w));
                    *(u32x4*)(merged + ro * DM + col0 + bj * HALF) = w; } }
    }
};
struct EpiResid {
    static constexpr bool PERM = false, AFTER_DRAIN = false, HAS_MID = false;
    const float* x; float* x1;
    __device__ __forceinline__ void operator()(const f32x4 (&acc)[2][2][4][2], const Unit& u, int wr, int wc, int fr, int fq) const {
        const int row0 = u.pm * BM + wr * 64 + fr, col0 = u.pn * BM + wc * 32 + 4 * fq;
#pragma unroll
        for (int ai = 0; ai < 2; ++ai)
#pragma unroll
            for (int m = 0; m < 4; ++m) { const size_t ro = (size_t)(row0 + ai * HALF + m * 16) * DM + col0;
#pragma unroll
                for (int bj = 0; bj < 2; ++bj)
#pragma unroll
                    for (int n = 0; n < 2; ++n) { const size_t o = ro + bj * HALF + n * 16; *(f32x4*)(x1 + o) = *(const f32x4*)(x + o) + acc[ai][bj][m][n]; } }
    }
};
struct EpiUp {
    static constexpr bool PERM = true, AFTER_DRAIN = false, HAS_MID = false;
    const float* egate; const int* cnt; bf16_t* act;
    __device__ __forceinline__ void operator()(const f32x4 (&acc)[2][2][4][2], const Unit& u, int wr, int wc, int fr, int fq) const {
        const int rl0 = wr * 64 + fr, col0 = u.pn * HALF + wc * 32 + 8 * fq; const int ce = cnt[u.e];
#pragma unroll
        for (int ai = 0; ai < 2; ++ai)
#pragma unroll
            for (int m = 0; m < 4; ++m) { const int rl = rl0 + ai * HALF + m * 16; const int ri = u.r0 + rl;
                const float rg = ri < ce ? egate[u.e * ECAP + ri] : 0.f;
                f32x4 a0, a1; const f32x4 g0 = acc[ai][0][m][0], g1 = acc[ai][0][m][1], u0 = acc[ai][1][m][0], u1 = acc[ai][1][m][1];
#pragma unroll
                for (int q = 0; q < 4; ++q) { a0[q] = g0[q] * fsigmoid(g0[q]) * u0[q] * rg; a1[q] = g1[q] * fsigmoid(g1[q]) * u1[q] * rg; }
                u32x4 w; w.x = cvt_pk_bf16(a0[0], a0[1]); w.y = cvt_pk_bf16(a0[2], a0[3]); w.z = cvt_pk_bf16(a1[0], a1[1]); w.w = cvt_pk_bf16(a1[2], a1[3]);
                *(u32x4*)(act + (size_t)(u.pm * BM + rl) * DE + col0) = w; }
    }
};
struct EpiDown {
    static constexpr bool PERM = true, AFTER_DRAIN = false, HAS_MID = false;
    const int* elist; const int* cnt; bf16_t *y0, *y1;
    __device__ __forceinline__ void operator()(const f32x4 (&acc)[2][2][4][2], const Unit& u, int wr, int wc, int fr, int fq) const {
        const int rl0 = wr * 64 + fr, col0 = u.pn * BM + wc * 32 + 8 * fq; const int ce = cnt[u.e];
#pragma unroll
        for (int ai = 0; ai < 2; ++ai)
#pragma unroll
            for (int m = 0; m < 4; ++m) { const int ri = u.r0 + rl0 + ai * HALF + m * 16;
                if (ri < ce) { const int t2 = elist[u.e * ECAP + ri]; bf16_t* yp = ((t2 & 1) ? y1 : y0) + (size_t)(t2 >> 1) * DM + col0;
#pragma unroll
                    for (int bj = 0; bj < 2; ++bj) { const f32x4 v0 = acc[ai][bj][m][0], v1 = acc[ai][bj][m][1];
                        u32x4 w; w.x = cvt_pk_bf16(v0[0], v0[1]); w.y = cvt_pk_bf16(v0[2], v0[3]); w.z = cvt_pk_bf16(v1[0], v1[1]); w.w = cvt_pk_bf16(v1[2], v1[3]);
                        *(u32x4*)(yp + bj * HALF) = w; } } }
    }
};
template <class Epi, class Sched, bool ALIGN_EPI = false, bool SP2 = false, bool GATHER = false>
__device__ __forceinline__ void gemm_phase(PG8_LAS unsigned char* lds, const Gemm g, const Sched& S, const Epi& E, const int wave_in) {
    int lane_; asm volatile("v_mbcnt_lo_u32_b32 %0, -1, 0\n\tv_mbcnt_hi_u32_b32 %0, -1, %0" : "=v"(lane_)); const int lane = lane_, wid = wave_in, tid = wid * 64 + lane, wr = wid >> 2, wc = wid & 3, fr = lane & 15, fq = lane >> 4;
    const int K = g.K, nt = K / BK;
    unsigned voffA[2], voffAh[2], voffB[2];
#pragma unroll
    for (int i = 0; i < 2; ++i) { int R, C; stage_rc(tid * 16 + i * 8192, R, C); const int Rb = Epi::PERM ? ((R & ~31) + perm32(R & 31)) : R;
        voffA[i] = (unsigned)(R * K + C) * 2u; voffAh[i] = voffA[i]; voffB[i] = (unsigned)(Rb * K + C) * 2u; }
    const size_t kstep = (size_t)(BK * 2);
    const size_t hstep = (size_t)HALF * K * 2;
    const size_t tstep = 2 * hstep;
    const unsigned ldsw = (unsigned)wid * 1024u;
    const int aoff = lds_byte(wr * 64 + fr, fq * 8), boff = lds_byte(wc * 32 + fr, fq * 8);
#define PG8_SA(b, h) (((b) * 2 + (h)) * HTB)
#define PG8_SB(b, h) ((4 + (b) * 2 + (h)) * HTB)
#define PG8_STAGE(bufoff, gbase, voff) do { _Pragma("unroll") for (int _i = 0; _i < 2; ++_i) \
        __builtin_amdgcn_global_load_lds((const unsigned*)((const char*)(gbase) + (voff)[_i]), (PG8_LAS unsigned*)(lds + (bufoff) + ldsw + _i * 8192), 16, 0, 0); } while (0)
#define PG8_STAGE_H1(bufoff, gbase, vo, voh) do { if constexpr (GATHER) { PG8_STAGE(bufoff, gbase, voh); } else { PG8_STAGE(bufoff, (gbase) + hstep, vo); } } while (0)
#define PG8_LDA(dst, b, h) do { _Pragma("unroll") for (int m = 0; m < 4; ++m) _Pragma("unroll") for (int k = 0; k < 2; ++k) dst[m][k] = *(const PG8_LAS bf16x8*)(lds + PG8_SA(b, h) + aoff + m * 2048 + k * 1024); } while (0)
#define PG8_LDB(dst, b, h) do { _Pragma("unroll") for (int n = 0; n < 2; ++n) _Pragma("unroll") for (int k = 0; k < 2; ++k) dst[n][k] = *(const PG8_LAS bf16x8*)(lds + PG8_SB(b, h) + boff + n * 2048 + k * 1024); } while (0)
#define PG8_MMA(ai, bj, At, Bt) do { __builtin_amdgcn_s_setprio(1); _Pragma("unroll") for (int m = 0; m < 4; ++m) _Pragma("unroll") for (int n = 0; n < 2; ++n) _Pragma("unroll") for (int k = 0; k < 2; ++k) \
        acc[ai][bj][m][n] = __builtin_amdgcn_mfma_f32_16x16x32_bf16(Bt[n][k], At[m][k], acc[ai][bj][m][n], 0, 0, 0); __builtin_amdgcn_s_setprio(0); } while (0)
#define PG8_WAIT_V(n) asm volatile("s_waitcnt vmcnt(" #n ")" ::: "memory")
#define PG8_WAIT_L(n) asm volatile("s_waitcnt lgkmcnt(" #n ")" ::: "memory")
#define PG8_BAR __builtin_amdgcn_s_barrier()
#define PG8_SCHED __builtin_amdgcn_sched_barrier(0)
    Unit cur, nxt; int ui = 0;
    if (!S.next(0, cur)) return;
    f32x4 acc[2][2][4][2];
#pragma unroll
    for (int a = 0; a < 2; ++a)
#pragma unroll
        for (int b = 0; b < 2; ++b)
#pragma unroll
            for (int m = 0; m < 4; ++m)
#pragma unroll
                for (int n = 0; n < 2; ++n) acc[a][b][m][n] = (f32x4){0.f, 0.f, 0.f, 0.f};
    bf16x8 At[4][2], B0[2][2], B1[2][2];
    const char* cA = (const char*)g.A + (GATHER ? (size_t)0 : (size_t)cur.pm * tstep); const char* cB = (const char*)g.Bt + (size_t)cur.pb * tstep;
    if constexpr (GATHER) { gather_offs(g, cur, tid, voffA, voffAh); }
    S.a_ready(cur);
    if constexpr (SP2) {
        PG8_STAGE(PG8_SB(0, 0), cB, voffB); PG8_STAGE(PG8_SB(0, 1), cB + hstep, voffB); PG8_STAGE(PG8_SA(0, 0), cA, voffA); PG8_STAGE_H1(PG8_SA(0, 1), cA, voffA, voffAh);
        if (wr == 1) PG8_BAR;
        PG8_WAIT_V(2); PG8_BAR;
        PG8_STAGE(PG8_SB(1, 0), cB + kstep, voffB); PG8_STAGE(PG8_SA(1, 0), cA + kstep, voffA); PG8_STAGE(PG8_SB(1, 1), cB + hstep + kstep, voffB);
        PG8_WAIT_V(6); PG8_BAR;
    } else {
        PG8_STAGE(PG8_SB(0, 0), cB, voffB); PG8_STAGE(PG8_SA(0, 0), cA, voffA); PG8_STAGE(PG8_SB(0, 1), cB + hstep, voffB); PG8_STAGE_H1(PG8_SA(0, 1), cA, voffA, voffAh);
        if (wr == 1) PG8_BAR;
        PG8_WAIT_V(4); PG8_BAR;
        PG8_STAGE(PG8_SB(1, 0), cB + kstep, voffB); PG8_STAGE(PG8_SA(1, 0), cA + kstep, voffA); PG8_STAGE(PG8_SB(1, 1), cB + hstep + kstep, voffB);
        PG8_WAIT_V(6); PG8_BAR;
    }
    for (;;) {
        const bool has_next = S.next(ui + 1, nxt);
        const char* nA = GATHER ? cA : (has_next ? (const char*)g.A + (size_t)nxt.pm * tstep : cA); const char* nB = has_next ? (const char*)g.Bt + (size_t)nxt.pb * tstep : cB;
        unsigned nvA[2], nvAh[2]; if constexpr (GATHER) { if (has_next) gather_offs(g, nxt, tid, nvA, nvAh); else { nvA[0] = voffA[0]; nvA[1] = voffA[1]; nvAh[0] = voffAh[0]; nvAh[1] = voffAh[1]; } }
        for (int t = 0; t < nt; t += 2) {
            const bool last = (t == nt - 2);
            if constexpr (Epi::HAS_MID) { if (t == nt / 2) { int l2_; asm volatile("v_mbcnt_lo_u32_b32 %0, -1, 0\n\tv_mbcnt_hi_u32_b32 %0, -1, %0" : "=v"(l2_)); const int fr2 = l2_ & 15, fq2 = l2_ >> 4; E.mid(acc, cur, wr, wc, fr2, fq2); } }
            const char* a1 = cA + (size_t)(t + 1) * kstep;
            const char* a2 = last ? nA : cA + (size_t)(t + 2) * kstep; const char* b2 = last ? nB : cB + (size_t)(t + 2) * kstep;
            const char* a3 = a2 + kstep; const char* b3 = b2 + kstep;
            unsigned v2A[2], v2Ah[2]; v2A[0] = (GATHER && last) ? nvA[0] : voffA[0]; v2A[1] = (GATHER && last) ? nvA[1] : voffA[1]; v2Ah[0] = (GATHER && last) ? nvAh[0] : voffAh[0]; v2Ah[1] = (GATHER && last) ? nvAh[1] : voffAh[1];
            if (last && has_next) S.a_ready(nxt);
            if constexpr (SP2) {
            PG8_LDB(B0, 0, 0); PG8_LDB(B1, 0, 1); PG8_SCHED; PG8_LDA(At, 0, 0); PG8_STAGE_H1(PG8_SA(1, 1), a1, voffA, voffAh);
            PG8_WAIT_V(8); PG8_WAIT_L(0); PG8_BAR; PG8_MMA(0, 0, At, B0); PG8_MMA(0, 1, At, B1); PG8_BAR; PG8_SCHED;
            PG8_LDA(At, 0, 1); PG8_STAGE(PG8_SB(0, 0), b2, voffB); PG8_STAGE(PG8_SB(0, 1), b2 + hstep, voffB); PG8_STAGE(PG8_SA(0, 0), a2, v2A);
            PG8_WAIT_V(8); PG8_WAIT_L(0); PG8_BAR; PG8_MMA(1, 0, At, B0); PG8_MMA(1, 1, At, B1); PG8_BAR; PG8_SCHED;
            PG8_LDB(B0, 1, 0); PG8_LDB(B1, 1, 1); PG8_SCHED; PG8_LDA(At, 1, 0); PG8_STAGE_H1(PG8_SA(0, 1), a2, v2A, v2Ah);
            PG8_WAIT_V(8); PG8_WAIT_L(0); PG8_BAR; PG8_MMA(0, 0, At, B0); PG8_MMA(0, 1, At, B1); PG8_BAR; PG8_SCHED;
            PG8_LDA(At, 1, 1); PG8_STAGE(PG8_SB(1, 0), b3, voffB); PG8_STAGE(PG8_SB(1, 1), b3 + hstep, voffB); PG8_STAGE(PG8_SA(1, 0), a3, v2A);
            PG8_WAIT_V(8); PG8_WAIT_L(0); PG8_BAR; PG8_MMA(1, 0, At, B0); PG8_MMA(1, 1, At, B1); PG8_BAR; PG8_SCHED;
            } else {
            PG8_LDB(B0, 0, 0); PG8_SCHED; PG8_LDA(At, 0, 0); PG8_STAGE_H1(PG8_SA(1, 1), a1, voffA, voffAh);
            PG8_WAIT_L(8); PG8_BAR; PG8_WAIT_L(0); PG8_MMA(0, 0, At, B0); PG8_BAR; PG8_SCHED;
            PG8_LDB(B1, 0, 1); PG8_STAGE(PG8_SB(0, 0), b2, voffB);
            PG8_BAR; PG8_WAIT_L(0); PG8_MMA(0, 1, At, B1); PG8_BAR;
            PG8_LDA(At, 0, 1); PG8_STAGE(PG8_SA(0, 0), a2, v2A);
            PG8_BAR; PG8_WAIT_L(0); PG8_MMA(1, 0, At, B0); PG8_BAR; PG8_SCHED;
            PG8_STAGE(PG8_SB(0, 1), b2 + hstep, voffB);
            PG8_WAIT_V(6); PG8_BAR; PG8_MMA(1, 1, At, B1); PG8_BAR;
            PG8_LDB(B0, 1, 0); PG8_SCHED; PG8_LDA(At, 1, 0); PG8_STAGE_H1(PG8_SA(0, 1), a2, v2A, v2Ah);
            PG8_WAIT_L(8); PG8_BAR; PG8_WAIT_L(0); PG8_MMA(0, 0, At, B0); PG8_BAR; PG8_SCHED;
            PG8_LDB(B1, 1, 1); PG8_STAGE(PG8_SB(1, 0), b3, voffB);
            PG8_BAR; PG8_WAIT_L(0); PG8_MMA(0, 1, At, B1); PG8_BAR;
            PG8_LDA(At, 1, 1); PG8_STAGE(PG8_SA(1, 0), a3, v2A);
            PG8_BAR; PG8_WAIT_L(0); PG8_MMA(1, 0, At, B0); PG8_BAR; PG8_SCHED;
            PG8_STAGE(PG8_SB(1, 1), b3 + hstep, voffB);
            PG8_WAIT_V(6); PG8_BAR; PG8_MMA(1, 1, At, B1); PG8_BAR;
            }
        }
        if constexpr (ALIGN_EPI) { if (wr == 0) PG8_BAR; }
        if constexpr (!Epi::AFTER_DRAIN) { int l2_; asm volatile("v_mbcnt_lo_u32_b32 %0, -1, 0\n\tv_mbcnt_hi_u32_b32 %0, -1, %0" : "=v"(l2_)); const int fr2 = l2_ & 15, fq2 = l2_ >> 4; E(acc, cur, wr, wc, fr2, fq2); S.done(cur); }
        if (!has_next) break;
#pragma unroll
        for (int a = 0; a < 2; ++a)
#pragma unroll
            for (int b = 0; b < 2; ++b)
#pragma unroll
                for (int m = 0; m < 4; ++m)
#pragma unroll
                    for (int n = 0; n < 2; ++n) acc[a][b][m][n] = (f32x4){0.f, 0.f, 0.f, 0.f};
        cur = nxt; cA = nA; cB = nB; ++ui;
        if constexpr (GATHER) { voffA[0] = nvA[0]; voffA[1] = nvA[1]; voffAh[0] = nvAh[0]; voffAh[1] = nvAh[1]; }
        if constexpr (ALIGN_EPI) { if (wr == 1) PG8_BAR; }
    }
    PG8_WAIT_V(0);
    if constexpr (!ALIGN_EPI) { if (wr == 0) PG8_BAR; }
    PG8_BAR;
    if constexpr (Epi::AFTER_DRAIN) { E.fused(acc, cur, wr, wc, fr, fq, lds, wid, lane); S.done(cur); }
#undef PG8_SA
#undef PG8_SB
#undef PG8_STAGE
#undef PG8_STAGE_H1
#undef PG8_LDA
#undef PG8_LDB
#undef PG8_MMA
#undef PG8_WAIT_V
#undef PG8_WAIT_L
#undef PG8_BAR
#undef PG8_SCHED
}
}

#ifndef PG8_SP2
#define PG8_SP2 true
#endif
#ifndef PG8_ALIGN
#define PG8_ALIGN true
#endif
#define GAS __attribute__((address_space(1)))
#define LAS __attribute__((address_space(3)))
typedef unsigned short bf16;
typedef unsigned v4u __attribute__((ext_vector_type(4)));
typedef float f32x4 __attribute__((ext_vector_type(4)));
typedef short bf16x8 __attribute__((ext_vector_type(8)));
typedef GAS unsigned gu32;
typedef GAS unsigned long long gu64;
#define RLX_AGENT __ATOMIC_RELAXED, __HIP_MEMORY_SCOPE_AGENT
#define LDS_WAIT() asm volatile("s_waitcnt lgkmcnt(0)" ::: "memory")
#define VM_WAIT() asm volatile("s_waitcnt vmcnt(0)" ::: "memory")
__device__ __forceinline__ unsigned long long rt() { return __builtin_amdgcn_s_memrealtime(); }
__device__ __forceinline__ unsigned f2bf(float f) { unsigned u = __builtin_bit_cast(unsigned, f); return (u + 0x7fffu + ((u >> 16) & 1u)) >> 16; }
__device__ __forceinline__ unsigned pk2(float lo, float hi) { return f2bf(lo) | (f2bf(hi) << 16); }

#define XB_TMO      128
#define XB_XCNT(j)  (256  + 64 * (j))
#define XB_XSUB(j)  (1280 + 64 * (j))
#define XB_XGEN(j)  (2304 + 64 * (j))
#define XB_TOP      3328
#define XB_TOPGEN   3392
#define XCD_BAR_WORDS 3456
#define XB_SPIN_CAP (1u << 18)

__device__ __forceinline__ unsigned xb_ld(unsigned* p)              { return __hip_atomic_load(p, __ATOMIC_RELAXED, __HIP_MEMORY_SCOPE_AGENT); }
__device__ __forceinline__ unsigned xb_add(unsigned* p, unsigned v) { return __hip_atomic_fetch_add(p, v, __ATOMIC_RELAXED, __HIP_MEMORY_SCOPE_AGENT); }
__device__ __forceinline__ unsigned xb_xcc_id() { return (unsigned)__builtin_amdgcn_s_getreg((3 << 11) | 20) & 0xFu; }
#define XB_SPIN(cond, bar) do { unsigned _sp = 0; while (cond) { __builtin_amdgcn_s_sleep(1); \
    if ((++_sp & 255u) == 0u) { if (xb_ld(&(bar)[XB_TMO])) break; if (_sp > XB_SPIN_CAP) { atomicAdd(&(bar)[XB_TMO], 1u); break; } } } } while (0)

__device__ __forceinline__ int xb_lane() { int x; asm volatile("v_mbcnt_lo_u32_b32 %0, -1, 0\n\tv_mbcnt_hi_u32_b32 %0, -1, %0" : "=v"(x)); return x; }
struct XcdBarrier {
    unsigned* bar; unsigned x; int wave;
    volatile LAS unsigned* st;
};

__device__ __forceinline__ XcdBarrier xcd_barrier_post(unsigned* bar, volatile LAS unsigned* st, int wave) {
    XcdBarrier b; b.bar = bar; b.x = xb_xcc_id(); b.st = st; b.wave = wave;
    if (wave == 0 && xb_lane() == 0) (void)xb_add(&bar[XB_XCNT(b.x)], 1u);
    return b;
}
__device__ __forceinline__ void xcd_barrier_complete(unsigned* bar, unsigned x, unsigned& nloc, unsigned& nx) {
    const unsigned G = gridDim.x * gridDim.y * gridDim.z;
    unsigned sum, cnt, mine, sp = 0u;
    for (;;) {
        sum = 0u; cnt = 0u; mine = 0u;
#pragma unroll
        for (unsigned j = 0; j < 16; ++j) { const unsigned c = xb_ld(&bar[XB_XCNT(j)]); sum += c; cnt += (c > 0u) ? 1u : 0u; mine = (j == x) ? c : mine; }
        if (sum == G) break;
        __builtin_amdgcn_s_sleep(1);
        if ((++sp & 255u) == 0u) { if (xb_ld(&bar[XB_TMO])) break; if (sp > XB_SPIN_CAP) { atomicAdd(&bar[XB_TMO], 1u); break; } }
    }
    nloc = mine > 0u ? mine : 1u; nx = cnt > 0u ? cnt : 1u;
}

__device__ __forceinline__ void xcd_barrier(const XcdBarrier& b) {
    asm volatile("s_waitcnt vmcnt(0)" ::: "memory");
    __syncthreads();
    if (b.wave == 0 && xb_lane() == 0) {
        unsigned* bar = b.bar;
        __builtin_amdgcn_s_waitcnt(0);
        unsigned nloc = b.st[0], nx = b.st[1];
        if (nloc == 0u) { xcd_barrier_complete(bar, b.x, nloc, nx); b.st[0] = nloc; b.st[1] = nx; }
        const unsigned old = xb_add(&bar[XB_XSUB(b.x)], 1u);
        const unsigned gen = old / nloc;
        if (old + 1u == (gen + 1u) * nloc) {
            __builtin_amdgcn_fence(__ATOMIC_RELEASE, "agent");
            asm volatile("s_waitcnt vmcnt(0)" ::: "memory");
            const unsigned og = xb_add(&bar[XB_TOP], 1u);
            const unsigned tg = og / nx;
            if (og + 1u == (tg + 1u) * nx) xb_add(&bar[XB_TOPGEN], 1u);
            else XB_SPIN(xb_ld(&bar[XB_TOPGEN]) == tg, bar);
            __builtin_amdgcn_fence(__ATOMIC_ACQUIRE, "agent");
            xb_add(&bar[XB_XGEN(b.x)], 1u);
            asm volatile("s_waitcnt vmcnt(0)" ::: "memory");
        } else {
            XB_SPIN(xb_ld(&bar[XB_XGEN(b.x)]) == gen, bar);
            __builtin_amdgcn_fence(__ATOMIC_ACQUIRE, "agent");
            asm volatile("s_waitcnt vmcnt(0)" ::: "memory");
        }
    }
    __syncthreads();
}


constexpr int NWAVES = 8;
constexpr int RING_OFF = 0, RING_BYTES = 131072;
constexpr int LDSCTL_OFF = 147456;
constexpr int MISC_OFF = LDSCTL_OFF + 320;
constexpr int SCR_OFF = 151552;
constexpr int LDS_BYTES = 163840;
constexpr int ECAP = pg8::ECAP;

__device__ __forceinline__ int lane_id_v() { int x; asm volatile("v_mbcnt_lo_u32_b32 %0, -1, 0\n\tv_mbcnt_hi_u32_b32 %0, -1, %0" : "=v"(x)); return x; }
__device__ __forceinline__ float wave_sum(float v) {
#pragma unroll
    for (int o = 1; o < 64; o <<= 1) v += __shfl_xor(v, o);
    return v;
}
__device__ __forceinline__ float bf2f(bf16 v) { return __uint_as_float((unsigned)v << 16); }
__device__ __forceinline__ float sigmoidf_(float x) { return 1.f / (1.f + expf(-x)); }

struct Args { const float* in[27]; float* out; unsigned char* ws; int ph_lo, ph_hi, nbar, pad; };

__device__ __forceinline__ void p0_transpose_item(const float* W, int ldw, int k0, int n0, bf16* WT, int Kd, int kdst, int drow, LAS float* scr, int lane) {
#pragma unroll 8
    for (int i = 0; i < 32; ++i) { const int kk = 2 * i + (lane >> 5); scr[kk * 33 + (lane & 31)] = W[(size_t)(k0 + kk) * ldw + n0 + (lane & 31)]; }
    LDS_WAIT(); asm volatile("" ::: "memory");
    const int c = lane & 7;
#pragma unroll
    for (int j = 0; j < 4; ++j) { const int n = (lane >> 3) + 8 * j; const LAS float* s = scr + (8 * c) * 33 + n;
        v4u o; o.x = pk2(s[0 * 33], s[1 * 33]); o.y = pk2(s[2 * 33], s[3 * 33]); o.z = pk2(s[4 * 33], s[5 * 33]); o.w = pk2(s[6 * 33], s[7 * 33]);
        *(GAS v4u*)(WT + (size_t)(drow + n) * Kd + kdst + 8 * c) = o; }
    LDS_WAIT(); asm volatile("" ::: "memory");
}
__device__ __forceinline__ void rms_row_to_bf16(const float* xrow, const float* g, bf16* orow, int lane) {
    const GAS f32x4* xr = (const GAS f32x4*)xrow + lane;
    f32x4 v[4]; float s = 0.f;
#pragma unroll
    for (int j = 0; j < 4; ++j) { v[j] = xr[64 * j]; s += (v[j].x * v[j].x + v[j].y * v[j].y) + (v[j].z * v[j].z + v[j].w * v[j].w); }
    const float rstd = rsqrtf(wave_sum(s) * (1.f / DM) + 1e-6f);
    GAS unsigned long long* o8 = (GAS unsigned long long*)orow + lane;
#pragma unroll
    for (int j = 0; j < 4; ++j) { const f32x4 gg = ((const GAS f32x4*)g)[lane + 64 * j];
        o8[64 * j] = (unsigned long long)pk2(v[j].x * rstd * gg.x, v[j].y * rstd * gg.y) | ((unsigned long long)pk2(v[j].z * rstd * gg.z, v[j].w * rstd * gg.w) << 32); }
}
__device__ __forceinline__ void route(const float (&lg)[NG], const float (&le)[NE], int& e1, int& e2, float& p1, float& p2) {
    int gi = 0; float gm = lg[0];
#pragma unroll
    for (int e = 1; e < NG; ++e) if (lg[e] > gm) { gm = lg[e]; gi = e; }
    float gs = 0.f;
#pragma unroll
    for (int e = 0; e < NG; ++e) gs += expf(lg[e] - gm);
    const float gprob = 1.f / gs;
    float l8[EPG];
#pragma unroll
    for (int e = 0; e < EPG; ++e) { float t = le[e];
#pragma unroll
        for (int q = 1; q < NG; ++q) t = (gi == q) ? le[q * EPG + e] : t;
        l8[e] = t; }
    int i1 = 0; float m1 = l8[0];
#pragma unroll
    for (int e = 1; e < EPG; ++e) if (l8[e] > m1) { m1 = l8[e]; i1 = e; }
    int i2 = 0; float m2 = -INFINITY;
#pragma unroll
    for (int e = 0; e < EPG; ++e) if (e != i1 && l8[e] > m2) { m2 = l8[e]; i2 = e; }
    const float ex = expf(m2 - m1);
    p1 = gprob / (1.f + ex); p2 = gprob * ex / (1.f + ex);
    e1 = gi * EPG + i1; e2 = gi * EPG + i2;
}


namespace attn {
typedef short s16x4 __attribute__((ext_vector_type(4)));
__device__ __forceinline__ s16x4 tr16(const LAS unsigned char* p) { return __builtin_bit_cast(s16x4, __builtin_amdgcn_ds_read_tr16_b64_v4i16((LAS s16x4*)p)); }
__device__ __forceinline__ unsigned cvtpk(float lo, float hi) { typedef float f2 __attribute__((ext_vector_type(2))); typedef __bf16 b2 __attribute__((ext_vector_type(2))); f2 v = {lo, hi}; b2 b = __builtin_convertvector(v, b2); return __builtin_bit_cast(unsigned, b); }
constexpr float LOG2E = 1.4426950408889634f;

__device__ __forceinline__ void attn_unit(LAS unsigned char* wl  , const bf16* __restrict__ QKV, const float* __restrict__ relb, bf16* __restrict__ BR, int b, int c, int h, int lane) {
    const int fr0 = lane & 15, fq0 = lane >> 4;
    LAS float* btab = (LAS float*)(wl + 8192);
    for (int i = lane; i < NREL; i += 64) btab[i] = relb[h * NREL + i] * LOG2E;
    const size_t row0 = (size_t)b * SEQ + (size_t)c * CHUNK;
    bf16x8 qf[4][2];
#pragma unroll
    for (int nt = 0; nt < 4; ++nt)
#pragma unroll
        for (int ks = 0; ks < 2; ++ks) qf[nt][ks] = *(const bf16x8*)(QKV + (row0 + 16 * nt + fr0) * ATT_PROJ + h * AD + 32 * ks + 8 * fq0);
    f32x4 o[4][4];
#pragma unroll
    for (int dt = 0; dt < 4; ++dt)
#pragma unroll
        for (int nt = 0; nt < 4; ++nt) o[dt][nt] = (f32x4){0.f, 0.f, 0.f, 0.f};
    float mrun[4], lrun[4];
#pragma unroll
    for (int nt = 0; nt < 4; ++nt) { mrun[nt] = -INFINITY; lrun[nt] = 0.f; }
    const float c128 = relb[h * NREL + 128] * LOG2E;
    const int j0 = c >= LEFT ? 0 : LEFT - c;
#pragma unroll 1
    for (int j = j0; j <= LEFT; ++j) {
        const size_t krow0 = (size_t)b * SEQ + (size_t)(c - LEFT + j) * CHUNK;
        int lane_ = lane; asm volatile("" : "+v"(lane_));
        const int fr = lane_ & 15, fq = lane_ >> 4;
        const bf16* kvb = QKV + krow0 * ATT_PROJ + h * AD;
        {
            v4u vst[8];
#pragma unroll
            for (int i = 0; i < 8; ++i) { const int idx = i * 64 + lane_, key = idx >> 3, dc = idx & 7; vst[i] = *(const v4u*)(kvb + (unsigned)(key * ATT_PROJ + 2 * AW + 8 * dc)); }
            asm volatile("s_waitcnt lgkmcnt(0)" ::: "memory");
#pragma unroll
            for (int i = 0; i < 8; ++i) { const int idx = i * 64 + lane_, key = idx >> 3, dc = idx & 7; *(LAS v4u*)(wl + (dc >> 1) * 2048 + key * 32 + (dc & 1) * 16) = vst[i]; }
        }
        const int delta = (LEFT - j) * CHUNK;
#pragma unroll
        for (int hf = 0; hf < 2; ++hf) {
            f32x4 s[4][2];
#pragma unroll
            for (int mt = 0; mt < 4; ++mt) {
                bf16x8 kf[2];
#pragma unroll
                for (int ks = 0; ks < 2; ++ks) kf[ks] = *(const bf16x8*)(kvb + (unsigned)((16 * mt + fr) * ATT_PROJ + AW + 32 * ks + 8 * fq));
#pragma unroll
                for (int n2 = 0; n2 < 2; ++n2) { f32x4 a = (f32x4){0.f, 0.f, 0.f, 0.f};
                    a = __builtin_amdgcn_mfma_f32_16x16x32_bf16(kf[0], qf[2 * hf + n2][0], a, 0, 0, 0);
                    a = __builtin_amdgcn_mfma_f32_16x16x32_bf16(kf[1], qf[2 * hf + n2][1], a, 0, 0, 0); s[mt][n2] = a; }
            }
            if (j < LEFT - 1) {
#pragma unroll
                for (int mt = 0; mt < 4; ++mt)
#pragma unroll
                    for (int n2 = 0; n2 < 2; ++n2)
#pragma unroll
                        for (int r = 0; r < 4; ++r) s[mt][n2][r] = s[mt][n2][r] * LOG2E + c128;
            } else {
#pragma unroll
                for (int mt = 0; mt < 4; ++mt)
#pragma unroll
                    for (int n2 = 0; n2 < 2; ++n2)
#pragma unroll
                        for (int r = 0; r < 4; ++r) { int rel = delta + (16 * (2 * hf + n2) + fr) - (16 * mt + 4 * fq + r); rel = rel > 64 ? 64 : rel;
                            s[mt][n2][r] = s[mt][n2][r] * LOG2E + btab[rel + 64]; }
            }
            bf16x8 pb[2][2];
#pragma unroll
            for (int n2 = 0; n2 < 2; ++n2) { const int nt = 2 * hf + n2;
                float mx = s[0][n2][0];
#pragma unroll
                for (int mt = 0; mt < 4; ++mt)
#pragma unroll
                    for (int r = 0; r < 4; ++r) mx = fmaxf(mx, s[mt][n2][r]);
                mx = fmaxf(mx, __shfl_xor(mx, 16)); mx = fmaxf(mx, __shfl_xor(mx, 32));
                const float mn = fmaxf(mrun[nt], mx), alpha = __builtin_amdgcn_exp2f(mrun[nt] - mn);
                mrun[nt] = mn;
                float ps = 0.f;
#pragma unroll
                for (int mt = 0; mt < 4; ++mt)
#pragma unroll
                    for (int r = 0; r < 4; ++r) { const float p = __builtin_amdgcn_exp2f(s[mt][n2][r] - mn); s[mt][n2][r] = p; ps += p; }
                ps += __shfl_xor(ps, 16); ps += __shfl_xor(ps, 32);
                lrun[nt] = lrun[nt] * alpha + ps;
#pragma unroll
                for (int dt = 0; dt < 4; ++dt) o[dt][nt] = o[dt][nt] * alpha;
#pragma unroll
                for (int kb = 0; kb < 2; ++kb) { v4u w;
                    w.x = cvtpk(s[2 * kb][n2][0], s[2 * kb][n2][1]); w.y = cvtpk(s[2 * kb][n2][2], s[2 * kb][n2][3]);
                    w.z = cvtpk(s[2 * kb + 1][n2][0], s[2 * kb + 1][n2][1]); w.w = cvtpk(s[2 * kb + 1][n2][2], s[2 * kb + 1][n2][3]);
                    pb[kb][n2] = __builtin_bit_cast(bf16x8, w); }
            }
#pragma unroll
            for (int kb = 0; kb < 2; ++kb)
#pragma unroll
                for (int dt = 0; dt < 4; ++dt) {
                    const LAS unsigned char* vp = wl + dt * 2048 + (32 * kb + 4 * fq + (fr >> 2)) * 32 + (fr & 3) * 8;
                    const s16x4 lo = tr16(vp), hi = tr16(vp + 16 * 32);
                    const bf16x8 va = __builtin_shufflevector(lo, hi, 0, 1, 2, 3, 4, 5, 6, 7);
#pragma unroll
                    for (int n2 = 0; n2 < 2; ++n2) o[dt][2 * hf + n2] = __builtin_amdgcn_mfma_f32_16x16x32_bf16(va, pb[kb][n2], o[dt][2 * hf + n2], 0, 0, 0);
                }
        }
    }
#pragma unroll
    for (int nt = 0; nt < 4; ++nt) { const float inv = 1.f / lrun[nt];
#pragma unroll
        for (int dt = 0; dt < 4; ++dt) { const f32x4 v = o[dt][nt] * inv;
            uint2 w; w.x = cvtpk(v[0], v[1]); w.y = cvtpk(v[2], v[3]);
            *(uint2*)(BR + (row0 + 16 * nt + fr0) * DM + h * AD + 16 * dt + 4 * fq0) = w; } }
    asm volatile("s_waitcnt lgkmcnt(0)" ::: "memory");
}
}

namespace rwkv {
typedef short s16x4 __attribute__((ext_vector_type(4)));
typedef unsigned u32x2 __attribute__((ext_vector_type(2)));
constexpr int S64 = 144, S128 = 272;
constexpr int O_AT = 0, O_BT = 9216, O_KT = 18432, O_RT = 27648, O_VV = 36864, O_LAB = 46080, O_LAK = 55296, O_ARB = 64512, O_ARK = 73728, O_LP2 = 82944, O_UU = 92160;
constexpr int O_LOGD = 109568, O_MISC = 125952;
constexpr int O_TW = O_LAB, O_AL = O_LAK, O_SG = O_ARB;
constexpr size_t ITEM_BYTES = 49152;
constexpr float LOG2E = 1.4426950408889634f;
__device__ __forceinline__ s16x4 tr16(const LAS unsigned char* p) { return __builtin_bit_cast(s16x4, __builtin_amdgcn_ds_read_tr16_b64_v4i16((LAS s16x4*)p)); }
__device__ __forceinline__ unsigned cvtpk(float lo, float hi) { typedef float f2 __attribute__((ext_vector_type(2))); typedef __bf16 b2 __attribute__((ext_vector_type(2))); f2 v = {lo, hi}; b2 b = __builtin_convertvector(v, b2); return __builtin_bit_cast(unsigned, b); }
__device__ __forceinline__ float blo(unsigned w) { return __uint_as_float(w << 16); }
__device__ __forceinline__ float bhi(unsigned w) { return __uint_as_float(w & 0xffff0000u); }
__device__ __forceinline__ f32x4 mf(bf16x8 a, bf16x8 b, f32x4 c) { return __builtin_amdgcn_mfma_f32_16x16x32_bf16(a, b, c, 0, 0, 0); }
__device__ __forceinline__ bf16x8 rd(const LAS unsigned char* m, int stride, int row, int k) { return *(const LAS bf16x8*)(m + row * stride + k * 2); }
__device__ __forceinline__ bf16x8 rdT(const LAS unsigned char* m, int stride, int k0, int n0, int fr, int fq) {
    const LAS unsigned char* p = m + (k0 + 8 * fq + (fr >> 2)) * stride + (n0 + 4 * (fr & 3)) * 2;
    const s16x4 lo = tr16(p), hi = tr16(p + 4 * stride);
    return __builtin_shufflevector(lo, hi, 0, 1, 2, 3, 4, 5, 6, 7);
}
__device__ __forceinline__ void st4(LAS unsigned char* m, int stride, int row, int col, f32x4 v) { u32x2 w; w.x = cvtpk(v[0], v[1]); w.y = cvtpk(v[2], v[3]); *(LAS u32x2*)(m + row * stride + col * 2) = w; }
__device__ __forceinline__ void gst4(bf16* p, f32x4 v) { u32x2 w; w.x = cvtpk(v[0], v[1]); w.y = cvtpk(v[2], v[3]); *(u32x2*)p = w; }
#define WG_BAR() do { asm volatile("s_waitcnt vmcnt(0) lgkmcnt(0)" ::: "memory"); __builtin_amdgcn_s_barrier(); asm volatile("" ::: "memory"); } while (0)

struct Par { const bf16* RW; const float *mu, *w0, *a0, *k_k, *k_a, *r_k, *gn_g, *gn_b; const bf16 *W2T, *A2T, *G2T; unsigned char* F; };

__device__ __forceinline__ void rwkv_prep_item(LAS unsigned char* L, const Par& P, int b, int c, int h, int wave, int lane) {
    const int tid = wave * 64 + lane, fr = lane & 15, fq = lane >> 4;
    const int item = (b * NCHUNK + c) * RH + h;
    bf16* GT = (bf16*)(P.F + (size_t)item * ITEM_BYTES); bf16* HTT = GT + 4096; bf16* RQ = GT + 8192; bf16* YL = GT + 12288; bf16* C1 = GT + 16384; bf16* C2 = GT + 20480;
    LAS float* invn = (LAS float*)(L + O_MISC); LAS float* bpart = invn + 64; LAS float* pc = invn + 192; LAS float* segsum = invn + 256;
    LAS float* LOGD = (LAS float*)(L + O_LOGD);
    {
        const int t = tid >> 3, part = tid & 7;
        const size_t row = (size_t)b * SEQ + (size_t)c * CHUNK + t;
        const bf16* cur = P.RW + row * RWKV_PROJ;
        const bool hasprev = (c * CHUNK + t) > 0;
        const bf16* prv = hasprev ? cur - RWKV_PROJ : cur;
        const int cols[7] = {h * RN + 8 * part, RWW + h * RN + 8 * part, 2 * RWW + h * RN + 8 * part, 3 * RWW + 8 * part, 3 * RWW + DLORA + 8 * part, 3 * RWW + DLORA + ALORA + 8 * part, 3 * RWW + DLORA + ALORA + 64 + 8 * part};
        float xs[7][8];
#pragma unroll
        for (int a = 0; a < 7; ++a) {
            const v4u cw = *(const v4u*)(cur + cols[a]); v4u pw = *(const v4u*)(prv + cols[a]); if (!hasprev) pw = (v4u){0u, 0u, 0u, 0u};
            const f32x4 m0 = *(const f32x4*)(P.mu + cols[a]), m1 = *(const f32x4*)(P.mu + cols[a] + 4);
            const float cv[8] = {blo(cw.x), bhi(cw.x), blo(cw.y), bhi(cw.y), blo(cw.z), bhi(cw.z), blo(cw.w), bhi(cw.w)};
            const float pv[8] = {blo(pw.x), bhi(pw.x), blo(pw.y), bhi(pw.y), blo(pw.z), bhi(pw.z), blo(pw.w), bhi(pw.w)};
            const float mv[8] = {m0[0], m0[1], m0[2], m0[3], m1[0], m1[1], m1[2], m1[3]};
#pragma unroll
            for (int q = 0; q < 8; ++q) xs[a][q] = cv[q] + (pv[q] - cv[q]) * mv[q];
        }
        float nk = 0.f;
        { const f32x4 k0 = *(const f32x4*)(P.k_k + h * RN + 8 * part), k1 = *(const f32x4*)(P.k_k + h * RN + 8 * part + 4);
          const float kv[8] = {k0[0], k0[1], k0[2], k0[3], k1[0], k1[1], k1[2], k1[3]};
#pragma unroll
          for (int q = 0; q < 8; ++q) { const float z = xs[1][q] * kv[q]; nk += z * z; } }
        nk += __shfl_xor(nk, 1); nk += __shfl_xor(nk, 2); nk += __shfl_xor(nk, 4);
        if (part == 0) invn[t] = 1.f / fmaxf(sqrtf(nk), 1e-12f);
#pragma unroll
        for (int q = 0; q < 8; ++q) { xs[3][q] = tanhf(xs[3][q]); xs[5][q] = 1.f / (1.f + __expf(-xs[5][q])); xs[6][q] = 1.f / (1.f + __expf(-xs[6][q])); }
        const int dst[7] = {O_RT + t * S64 + 16 * part, O_KT + t * S64 + 16 * part, O_VV + t * S64 + 16 * part, O_TW + t * S64 + 16 * part, O_AL + t * S64 + 16 * part, O_SG + t * S128 + 16 * part, O_SG + t * S128 + 128 + 16 * part};
#pragma unroll
        for (int a = 0; a < 7; ++a) { v4u w; w.x = cvtpk(xs[a][0], xs[a][1]); w.y = cvtpk(xs[a][2], xs[a][3]); w.z = cvtpk(xs[a][4], xs[a][5]); w.w = cvtpk(xs[a][6], xs[a][7]); *(LAS v4u*)(L + dst[a]) = w; }
    }
    WG_BAR();
    {
        const int mt = wave & 3, t = 16 * mt + fr;
        float gk[2][4], vk[2][4]; float bsum = 0.f;
#pragma unroll
        for (int n2 = 0; n2 < 2; ++n2) {
            const int nt = 2 * (wave >> 2) + n2, j0 = 16 * nt + 4 * fq, cj = h * RN + j0;
            f32x4 ws = {0.f, 0.f, 0.f, 0.f}, as = ws, gs = ws;
            const bf16* w2r = P.W2T + (size_t)(h * RN + 16 * nt + fr) * DLORA; const bf16* a2r = P.A2T + (size_t)(h * RN + 16 * nt + fr) * ALORA; const bf16* g2r = P.G2T + (size_t)(h * RN + 16 * nt + fr) * GLORA;
#pragma unroll
            for (int ks = 0; ks < 2; ++ks) { ws = mf(*(const bf16x8*)(w2r + 32 * ks + 8 * fq), rd(L + O_TW, S64, t, 32 * ks + 8 * fq), ws); as = mf(*(const bf16x8*)(a2r + 32 * ks + 8 * fq), rd(L + O_AL, S64, t, 32 * ks + 8 * fq), as); }
#pragma unroll
            for (int ks = 0; ks < 4; ++ks) gs = mf(*(const bf16x8*)(g2r + 32 * ks + 8 * fq), rd(L + O_SG, S128, t, 32 * ks + 8 * fq), gs);
            const f32x4 w0v = *(const f32x4*)(P.w0 + cj), a0v = *(const f32x4*)(P.a0 + cj), kkv = *(const f32x4*)(P.k_k + cj), kav = *(const f32x4*)(P.k_a + cj), rkv = *(const f32x4*)(P.r_k + cj), gg = *(const f32x4*)(P.gn_g + cj);
            const u32x2 rw = *(const LAS u32x2*)(L + O_RT + t * S64 + j0 * 2), kw = *(const LAS u32x2*)(L + O_KT + t * S64 + j0 * 2), vw = *(const LAS u32x2*)(L + O_VV + t * S64 + j0 * 2);
            const float rr[4] = {blo(rw.x), bhi(rw.x), blo(rw.y), bhi(rw.y)}, kr[4] = {blo(kw.x), bhi(kw.x), blo(kw.y), bhi(kw.y)}, vr[4] = {blo(vw.x), bhi(vw.x), blo(vw.y), bhi(vw.y)};
            const float inv = invn[t];
            f32x4 al, be, kp, ld, c1;
#pragma unroll
            for (int q = 0; q < 4; ++q) {
                const float x = -(w0v[q] + ws[q]);
                const float sp = x > 20.f ? x : log1pf(__expf(x));
                ld[q] = -__expf(-sp - 0.5f);
                const float a = 1.f / (1.f + __expf(-(a0v[q] + as[q])));
                const float kkn = kr[q] * kkv[q] * inv;
                al[q] = -kkn; be[q] = kkn * a; kp[q] = kr[q] * (1.f + (a - 1.f) * kav[q]);
                bsum += rr[q] * kp[q] * rkv[q];
                gk[n2][q] = gs[q]; vk[n2][q] = vr[q]; c1[q] = gg[q] * gs[q];
            }
            st4(L + O_AT, S64, t, j0, al); st4(L + O_BT, S64, t, j0, be); st4(L + O_KT, S64, t, j0, kp);
            *(LAS f32x4*)(LOGD + t * 64 + j0) = ld;
            gst4(C1 + t * 64 + j0, c1);
        }
        bsum += __shfl_xor(bsum, 16); bsum += __shfl_xor(bsum, 32);
        if (fq == 0) bpart[(wave >> 2) * 64 + t] = bsum;
        WG_BAR();
        const float bonus = bpart[t] + bpart[64 + t];
#pragma unroll
        for (int n2 = 0; n2 < 2; ++n2) { const int j0 = 16 * (2 * (wave >> 2) + n2) + 4 * fq, cj = h * RN + j0; const f32x4 gb = *(const f32x4*)(P.gn_b + cj);
            f32x4 c2; for (int q = 0; q < 4; ++q) c2[q] = (gb[q] + bonus * vk[n2][q]) * gk[n2][q];
            gst4(C2 + t * 64 + j0, c2); }
    }
    {
        const int j = lane, sg = wave; float lp[8], ld8[8]; float run = 0.f;
#pragma unroll
        for (int i = 0; i < 8; ++i) { ld8[i] = LOGD[(8 * sg + i) * 64 + j]; run += ld8[i]; lp[i] = run; }
        segsum[sg * 64 + j] = run;
        WG_BAR();
        float off = 0.f;
#pragma unroll
        for (int s = 0; s < 7; ++s) off += (s < sg) ? segsum[s * 64 + j] : 0.f;
#pragma unroll
        for (int i = 0; i < 8; ++i) { const int t = 8 * sg + i; const float l = lp[i] + off;
            const float e1 = __expf(l - ld8[i]), e2 = __expf(-l), e3 = __expf(l);
            LAS bf16* pa = (LAS bf16*)(L + O_AT + t * S64) + j; LAS bf16* pb = (LAS bf16*)(L + O_BT + t * S64) + j; LAS bf16* pk = (LAS bf16*)(L + O_KT + t * S64) + j; LAS bf16* pr = (LAS bf16*)(L + O_RT + t * S64) + j;
            *pa = (bf16)f2bf(bf2f(*pa) * e1); *pb = (bf16)f2bf(bf2f(*pb) * e2); *pk = (bf16)f2bf(bf2f(*pk) * e2); *pr = (bf16)f2bf(bf2f(*pr) * e3);
            if (t == 63) pc[j] = e3; }
    }
    WG_BAR();
    {
        const int p = wave >> 1; const int ox = (p < 2) ? O_AT : O_RT, oz = (p & 1) ? O_KT : O_BT; const int od = O_LAB + p * 9216; const bool strict = p < 2;
#pragma unroll
        for (int m2 = 0; m2 < 2; ++m2) { const int mt = 2 * (wave & 1) + m2;
            const bf16x8 x0 = rd(L + ox, S64, 16 * mt + fr, 8 * fq), x1 = rd(L + ox, S64, 16 * mt + fr, 32 + 8 * fq);
#pragma unroll
            for (int nt = 0; nt < 4; ++nt) {
                f32x4 d = {0.f, 0.f, 0.f, 0.f};
                if (nt <= mt) { d = mf(rd(L + oz, S64, 16 * nt + fr, 8 * fq), x0, d); d = mf(rd(L + oz, S64, 16 * nt + fr, 32 + 8 * fq), x1, d);
                    if (nt == mt) { const int t = fr;
#pragma unroll
                        for (int q = 0; q < 4; ++q) { const int i = 4 * fq + q; if (strict ? (i >= t) : (i > t)) d[q] = 0.f; } } }
                st4(L + od, S64, 16 * mt + fr, 16 * nt + 4 * fq, d);
            } }
    }
    WG_BAR();
    {
        const int nt = wave & 3;
        const bf16x8 a0 = rdT(L + O_VV, S64, 0, 16 * nt, fr, fq), a1 = rdT(L + O_VV, S64, 32, 16 * nt, fr, fq);
#pragma unroll
        for (int m2 = 0; m2 < 2; ++m2) { const int mt = 2 * (wave >> 2) + m2; f32x4 d = {0.f, 0.f, 0.f, 0.f};
            d = mf(a0, rd(L + O_LAK, S64, 16 * mt + fr, 8 * fq), d); d = mf(a1, rd(L + O_LAK, S64, 16 * mt + fr, 32 + 8 * fq), d);
            st4(L + O_UU, S128, 16 * mt + fr, 64 + 16 * nt + 4 * fq, d); }
        { const int t = tid >> 3, part = tid & 7; *(LAS v4u*)(L + O_UU + t * S128 + 16 * part) = *(const LAS v4u*)(L + O_AT + t * S64 + 16 * part); }
    }
    WG_BAR();
#pragma unroll 1
    for (int rnd = 0; rnd < 6; ++rnd) {
        const LAS unsigned char* Lp = L + ((rnd & 1) ? O_LP2 : O_LAB); LAS unsigned char* Ln = L + ((rnd & 1) ? O_LAB : O_LP2);
        {
            const bf16x8 u0 = rdT(L + O_UU, S128, 0, 16 * wave, fr, fq), u1 = rdT(L + O_UU, S128, 32, 16 * wave, fr, fq);
            f32x4 d[4];
#pragma unroll
            for (int mt = 0; mt < 4; ++mt) { d[mt] = (f32x4){0.f, 0.f, 0.f, 0.f}; d[mt] = mf(u0, rd(Lp, S64, 16 * mt + fr, 8 * fq), d[mt]); d[mt] = mf(u1, rd(Lp, S64, 16 * mt + fr, 32 + 8 * fq), d[mt]); }
#pragma unroll
            for (int mt = 0; mt < 4; ++mt) { LAS u32x2* up = (LAS u32x2*)(L + O_UU + (16 * mt + fr) * S128 + (16 * wave + 4 * fq) * 2); const u32x2 w = *up;
                f32x4 v = {blo(w.x) + d[mt][0], bhi(w.x) + d[mt][1], blo(w.y) + d[mt][2], bhi(w.y) + d[mt][3]};
                u32x2 o; o.x = cvtpk(v[0], v[1]); o.y = cvtpk(v[2], v[3]); *up = o; }
        }
        if (rnd < 5) {
            const int nt = wave & 3;
            const bf16x8 a0 = rdT(Lp, S64, 0, 16 * nt, fr, fq), a1 = rdT(Lp, S64, 32, 16 * nt, fr, fq);
#pragma unroll
            for (int m2 = 0; m2 < 2; ++m2) { const int mt = 2 * (wave >> 2) + m2; f32x4 d = {0.f, 0.f, 0.f, 0.f};
                d = mf(a0, rd(Lp, S64, 16 * mt + fr, 8 * fq), d); d = mf(a1, rd(Lp, S64, 16 * mt + fr, 32 + 8 * fq), d);
                st4(Ln, S64, 16 * mt + fr, 16 * nt + 4 * fq, d); }
        }
        WG_BAR();
    }
    if (wave < 4) {
        const int mt = wave, t = 16 * mt + fr;
        const bf16x8 b0 = rd(L + O_ARB, S64, t, 8 * fq), b1 = rd(L + O_ARB, S64, t, 32 + 8 * fq), k0 = rd(L + O_ARK, S64, t, 8 * fq), k1 = rd(L + O_ARK, S64, t, 32 + 8 * fq);
#pragma unroll
        for (int nt = 0; nt < 8; ++nt) { f32x4 d = {0.f, 0.f, 0.f, 0.f};
            d = mf(rdT(L + O_UU, S128, 0, 16 * nt, fr, fq), b0, d); d = mf(rdT(L + O_UU, S128, 32, 16 * nt, fr, fq), b1, d);
            if (nt < 4) { const u32x2 w = *(const LAS u32x2*)(L + O_RT + t * S64 + (16 * nt + 4 * fq) * 2); d[0] += blo(w.x); d[1] += bhi(w.x); d[2] += blo(w.y); d[3] += bhi(w.y);
                gst4(RQ + t * 64 + 16 * nt + 4 * fq, d); }
            else { d = mf(rdT(L + O_VV, S64, 0, 16 * (nt - 4), fr, fq), k0, d); d = mf(rdT(L + O_VV, S64, 32, 16 * (nt - 4), fr, fq), k1, d);
                gst4(YL + t * 64 + 16 * (nt - 4) + 4 * fq, d); } }
    } else {
        const int kt = wave - 4, k1i = 16 * kt + fr;
        const bf16x8 bb0 = rdT(L + O_BT, S64, 0, 16 * kt, fr, fq), bb1 = rdT(L + O_BT, S64, 32, 16 * kt, fr, fq);
        const float pk1 = pc[k1i];
#pragma unroll
        for (int nt = 0; nt < 4; ++nt) { f32x4 d = {0.f, 0.f, 0.f, 0.f};
            d = mf(rdT(L + O_UU, S128, 0, 16 * nt, fr, fq), bb0, d); d = mf(rdT(L + O_UU, S128, 32, 16 * nt, fr, fq), bb1, d);
#pragma unroll
            for (int q = 0; q < 4; ++q) { if (16 * nt + 4 * fq + q == k1i) d[q] += 1.f; d[q] *= pk1; }
            gst4(GT + k1i * 64 + 16 * nt + 4 * fq, d); }
        const bf16x8 ab0 = rdT(L + O_BT, S64, 0, 16 * kt, fr, fq), ab1 = rdT(L + O_BT, S64, 32, 16 * kt, fr, fq), ak0 = rdT(L + O_KT, S64, 0, 16 * kt, fr, fq), ak1 = rdT(L + O_KT, S64, 32, 16 * kt, fr, fq);
        const f32x4 pq = *(const LAS f32x4*)(pc + 16 * kt + 4 * fq);
#pragma unroll
        for (int vt = 0; vt < 4; ++vt) { f32x4 d = {0.f, 0.f, 0.f, 0.f};
            d = mf(ab0, rdT(L + O_UU, S128, 0, 64 + 16 * vt, fr, fq), d); d = mf(ab1, rdT(L + O_UU, S128, 32, 64 + 16 * vt, fr, fq), d);
            d = mf(ak0, rdT(L + O_VV, S64, 0, 16 * vt, fr, fq), d); d = mf(ak1, rdT(L + O_VV, S64, 32, 16 * vt, fr, fq), d);
            d = d * pq;
            gst4(HTT + (16 * vt + fr) * 64 + 16 * kt + 4 * fq, d); }
    }
    WG_BAR();
}

#define R3_LOAD(S, cc) do { const int item_ = (b * NCHUNK + (cc)) * RH + h; const bf16* GT_ = (const bf16*)(F + (size_t)item_ * ITEM_BYTES); const bf16* HTT_ = GT_ + 4096; \
    _Pragma("unroll") for (int mt = 0; mt < 4; ++mt) { \
        _Pragma("unroll") for (int kb = 0; kb < 2; ++kb) { ga##S[mt][kb][0] = *(const u32x2*)(GT_ + (16 * mt + fr) * 64 + 32 * kb + 4 * fq); ga##S[mt][kb][1] = *(const u32x2*)(GT_ + (16 * mt + fr) * 64 + 32 * kb + 16 + 4 * fq); } \
        hv##S[mt] = *(const u32x2*)(HTT_ + (16 * vt + fr) * 64 + 16 * mt + 4 * fq); } } while (0)
#define R3_STEP(S, cc) do { const int c_ = (cc); const int item_ = (b * NCHUNK + c_) * RH + h; bf16* tt_ = TT + (size_t)item_ * 4096; u32x2 tp[4]; \
    _Pragma("unroll") for (int mt = 0; mt < 4; ++mt) { tp[mt].x = cvtpk(T[mt][0], T[mt][1]); tp[mt].y = cvtpk(T[mt][2], T[mt][3]); *(u32x2*)(tt_ + (16 * vt + fr) * 64 + 16 * mt + 4 * fq) = tp[mt]; } \
    if (c_ < NCHUNK - 1) { bf16x8 pb[2]; \
        _Pragma("unroll") for (int kb = 0; kb < 2; ++kb) { v4u w; w.x = tp[2 * kb].x; w.y = tp[2 * kb].y; w.z = tp[2 * kb + 1].x; w.w = tp[2 * kb + 1].y; pb[kb] = __builtin_bit_cast(bf16x8, w); } \
        _Pragma("unroll") for (int mt = 0; mt < 4; ++mt) { f32x4 tn = (f32x4){blo(hv##S[mt].x), bhi(hv##S[mt].x), blo(hv##S[mt].y), bhi(hv##S[mt].y)}; \
            _Pragma("unroll") for (int kb = 0; kb < 2; ++kb) { v4u w; w.x = ga##S[mt][kb][0].x; w.y = ga##S[mt][kb][0].y; w.z = ga##S[mt][kb][1].x; w.w = ga##S[mt][kb][1].y; tn = mf(__builtin_bit_cast(bf16x8, w), pb[kb], tn); } \
            T[mt] = tn; } \
        if (c_ + 4 < NCHUNK - 1) R3_LOAD(S, c_ + 4); } } while (0)
__device__ __forceinline__ void rwkv_scan(const unsigned char* F, bf16* TT, int job, int lane) {
    const int fr = lane & 15, fq = lane >> 4;
    const int chain = job >> 2, vt = job & 3, b = chain >> 3, h = chain & 7;
    f32x4 T[4];
#pragma unroll
    for (int mt = 0; mt < 4; ++mt) T[mt] = (f32x4){0.f, 0.f, 0.f, 0.f};
    u32x2 ga0[4][2][2], ga1[4][2][2], ga2[4][2][2], ga3[4][2][2], hv0[4], hv1[4], hv2[4], hv3[4];
    R3_LOAD(0, 0); R3_LOAD(1, 1); R3_LOAD(2, 2); R3_LOAD(3, 3);
#pragma unroll 1
    for (int c0 = 0; c0 < NCHUNK; c0 += 4) { R3_STEP(0, c0); R3_STEP(1, c0 + 1); R3_STEP(2, c0 + 2); R3_STEP(3, c0 + 3); }
}

__device__ __forceinline__ void rwkv_out_item(const unsigned char* F, const bf16* TT, bf16* BR, int item, int lane) {
    const int fr = lane & 15, fq = lane >> 4;
    const int h = item & 7, bc = item >> 3;
    const bf16* GT = (const bf16*)(F + (size_t)item * ITEM_BYTES); const bf16* RQ = GT + 8192; const bf16* YL = GT + 12288; const bf16* C1 = GT + 16384; const bf16* C2 = GT + 20480;
    const bf16* tt = TT + (size_t)item * 4096;
    bf16x8 ta[4][2], rb[4][2];
#pragma unroll
    for (int i = 0; i < 4; ++i)
#pragma unroll
        for (int ks = 0; ks < 2; ++ks) { ta[i][ks] = *(const bf16x8*)(tt + (16 * i + fr) * 64 + 32 * ks + 8 * fq); rb[i][ks] = *(const bf16x8*)(RQ + (16 * i + fr) * 64 + 32 * ks + 8 * fq); }
#pragma unroll
    for (int nt = 0; nt < 4; ++nt) {
        const int t = 16 * nt + fr;
        f32x4 y[4]; float s = 0.f;
#pragma unroll
        for (int mt = 0; mt < 4; ++mt) {
            const u32x2 w = *(const u32x2*)(YL + t * 64 + 16 * mt + 4 * fq);
            f32x4 d = {blo(w.x), bhi(w.x), blo(w.y), bhi(w.y)};
            d = mf(ta[mt][0], rb[nt][0], d); d = mf(ta[mt][1], rb[nt][1], d);
            y[mt] = d; s += (d[0] + d[1]) + (d[2] + d[3]);
        }
        s += __shfl_xor(s, 16); s += __shfl_xor(s, 32);
        const float mean = s * (1.f / 64.f); float q = 0.f;
#pragma unroll
        for (int mt = 0; mt < 4; ++mt) { y[mt] = y[mt] - mean; q += (y[mt][0] * y[mt][0] + y[mt][1] * y[mt][1]) + (y[mt][2] * y[mt][2] + y[mt][3] * y[mt][3]); }
        q += __shfl_xor(q, 16); q += __shfl_xor(q, 32);
        const float rstd = rsqrtf(q * (1.f / 64.f) + 64e-5f);
#pragma unroll
        for (int mt = 0; mt < 4; ++mt) { const u32x2 a = *(const u32x2*)(C1 + t * 64 + 16 * mt + 4 * fq), bq = *(const u32x2*)(C2 + t * 64 + 16 * mt + 4 * fq);
            f32x4 o = {y[mt][0] * rstd * blo(a.x) + blo(bq.x), y[mt][1] * rstd * bhi(a.x) + bhi(bq.x), y[mt][2] * rstd * blo(a.y) + blo(bq.y), y[mt][3] * rstd * bhi(a.y) + bhi(bq.y)};
            gst4(BR + ((size_t)bc * 64 + t) * DM + RWW + h * RN + 16 * mt + 4 * fq, o); }
    }
}
}

__global__ void __launch_bounds__(NWAVES * 64, 2) mk_fwd(Args args) {
    extern __shared__ __attribute__((aligned(16))) unsigned char lds[];
    LAS unsigned char* L = (LAS unsigned char*)lds;
    volatile LAS unsigned* MISC = (volatile LAS unsigned*)(L + MISC_OFF);
    const int wave = __builtin_amdgcn_readfirstlane((int)threadIdx.x >> 6);
#define LANE_TID const int lane = lane_id_v(), tid = wave * 64 + lane; (void)tid; (void)lane;
    const int G = gridDim.x; const int bx = blockIdx.x; const int vcu = (G % 8 == 0) ? (bx % 8) * (G / 8) + bx / 8 : bx;
    unsigned char* ws = args.ws;
    gu32* ctl = (gu32*)(ws + WS_CTL);
    { LANE_TID for (int u = tid; u < 4096 / 4; u += NWAVES * 64) ((LAS unsigned*)(L + LDSCTL_OFF))[u] = 0u; }
    __syncthreads();
    XcdBarrier bar; bar.bar = (unsigned*)(ctl + CW_BAR); bar.x = 0; bar.st = nullptr; bar.wave = wave;
    if (args.nbar > 0) bar = xcd_barrier_post((unsigned*)(ctl + CW_BAR), MISC + 8, wave);
    const int lo = args.ph_lo, hi = args.ph_hi;
#define IN(k) (lo <= (k) && (k) < hi)
#define BOTH(k) (IN(k) && IN((k) + 1))
    const int gw = vcu * NWAVES + wave, NGW = G * NWAVES;
    bf16* XN = (bf16*)(ws + WS_XN); bf16* WIN = (bf16*)(ws + WS_WIN); bf16* WBR2 = (bf16*)(ws + WS_WBR2); bf16* WOUT = (bf16*)(ws + WS_WOUT);
    bf16* QKV = (bf16*)(ws + WS_QKV); bf16* RW = (bf16*)(ws + WS_RW); bf16* GATES = (bf16*)args.out; bf16* BR = (bf16*)(ws + WS_BR);
    bf16* MERGED = (bf16*)(ws + WS_MERGED); bf16* H2 = (bf16*)(ws + WS_H2); bf16* WUP = (bf16*)(ws + WS_WUP); bf16* WDN = (bf16*)(ws + WS_WDN);
    bf16* ACT = (bf16*)(ws + WS_ACT); bf16* Y0 = (bf16*)(ws + WS_Y0); bf16* Y1 = (bf16*)(ws + WS_Y1);
    int* elist = (int*)(ws + WS_ELIST); float* egate = (float*)(ws + WS_EGATE); int* cnt = (int*)(ws + WS_CTL) + CW_CNT;
    float* X1 = args.out;

    if (IN(0)) { LANE_TID
        LAS float* scr = (LAS float*)(L + RING_OFF + wave * 16384);
        constexpr int I_IN = (DM / 64) * (D_IN / 32), I_BA = (AW / 64) * (DM / 32), I_OUT = (DM / 64) * (DM / 32);
        constexpr int I_LO = 16 + 16 + 32;
        constexpr int NITEMS = I_IN + 2 * I_BA + I_OUT + I_LO;
        for (int it = gw; it < NITEMS; it += NGW) {
            int r = it;
            if (r < I_IN) { const int nb = D_IN / 32; p0_transpose_item(args.in[2], D_IN, 64 * (r / nb), 32 * (r % nb), WIN, DM, 64 * (r / nb), 32 * (r % nb), scr, lane); continue; } r -= I_IN;
            if (r < I_BA) { const int nb = DM / 32; p0_transpose_item(args.in[15], DM, 64 * (r / nb), 32 * (r % nb), WBR2, DM, 64 * (r / nb), 32 * (r % nb), scr, lane); continue; } r -= I_BA;
            if (r < I_BA) { const int nb = DM / 32; p0_transpose_item(args.in[16], DM, 64 * (r / nb), 32 * (r % nb), WBR2, DM, AW + 64 * (r / nb), 32 * (r % nb), scr, lane); continue; } r -= I_BA;
            if (r < I_OUT) { const int nb = DM / 32; p0_transpose_item(args.in[17], DM, 64 * (r / nb), 32 * (r % nb), WOUT, DM, 64 * (r / nb), 32 * (r % nb), scr, lane); continue; } r -= I_OUT;
            if (r < 16) { p0_transpose_item(args.in[6], RWW, 0, 32 * r, (bf16*)(ws + WS_W2T), DLORA, 0, 32 * r, scr, lane); continue; } r -= 16;
            if (r < 16) { p0_transpose_item(args.in[8], RWW, 0, 32 * r, (bf16*)(ws + WS_A2T), ALORA, 0, 32 * r, scr, lane); continue; } r -= 16;
            { p0_transpose_item(args.in[9], RWW, 64 * (r >> 4), 32 * (r & 15), (bf16*)(ws + WS_G2T), GLORA, 64 * (r >> 4), 32 * (r & 15), scr, lane); }
        }
        for (int m = gw; m < M; m += NGW) rms_row_to_bf16(args.in[0] + (size_t)m * DM, args.in[1], XN + (size_t)m * DM, lane);
        if (BOTH(0)) xcd_barrier(bar);
    }
    if (IN(1)) { LANE_TID
        pg8::Gemm g{XN, WIN, M, D_IN, DM, nullptr, nullptr}; pg8::StaticOrder S; S.init(M, D_IN, G, (int)blockIdx.x);
        pg8::EpiProj E{QKV, RW, GATES};
        pg8::gemm_phase<pg8::EpiProj, pg8::StaticOrder, true, true, false>(L + RING_OFF, g, S, E, wave);
        if (BOTH(1)) xcd_barrier(bar);
    }
    if (IN(2)) { LANE_TID
        rwkv::Par P{RW, args.in[4], args.in[5], args.in[7], args.in[10], args.in[11], args.in[12], args.in[13], args.in[14], (const bf16*)(ws + WS_W2T), (const bf16*)(ws + WS_A2T), (const bf16*)(ws + WS_G2T), ws + WS_F};
#pragma unroll 1
        for (int it = vcu; it < BATCH * NCHUNK * RH; it += G) rwkv::rwkv_prep_item(L, P, it >> 8, (it >> 3) & 31, it & 7, wave, lane);
        if (BOTH(2)) xcd_barrier(bar);
    }
    if (IN(3)) { LANE_TID
        if (wave == 0) { for (int job = bx; job < BATCH * RH * 4; job += G) rwkv::rwkv_scan(ws + WS_F, (bf16*)(ws + WS_TT), job, lane); }
        for (int unit = vcu; unit < BATCH * NCHUNK; unit += G) attn::attn_unit(L + wave * 16384, QKV, args.in[3], BR, unit >> 5, unit & 31, wave, lane);
        if (BOTH(3)) xcd_barrier(bar);
    }
    if (IN(4)) { LANE_TID
        for (int it = gw; it < BATCH * NCHUNK * RH; it += NGW) rwkv::rwkv_out_item(ws + WS_F, (const bf16*)(ws + WS_TT), BR, it, lane);
        if (BOTH(4)) xcd_barrier(bar);
    }
    if (IN(5)) { LANE_TID
        { pg8::Gemm g{BR, WBR2, M, DM, DM, nullptr, nullptr}; pg8::StaticOrder S; S.init(M, DM, G, (int)blockIdx.x);
          pg8::EpiMerge E{GATES, MERGED};
          pg8::gemm_phase<pg8::EpiMerge, pg8::StaticOrder, true, true, false>(L + RING_OFF, g, S, E, wave); }
        LAS float* scr = (LAS float*)(L + RING_OFF + wave * 16384);
        for (int it = gw; it < NE * 384; it += NGW) {
            const int e = it / 384, r = it % 384;
            if (r < 256) { const int up = r >> 7, q = r & 127, kb = q >> 3, nb = q & 7, n0 = 32 * nb;
                p0_transpose_item(args.in[up ? 24 : 23] + (size_t)e * DM * DE, DE, 64 * kb, n0, WUP, DM, 64 * kb, e * 512 + (n0 >> 7) * 256 + (n0 & 127) + up * 128, scr, lane); }
            else { const int q = r - 256, kb = q >> 5, nb = q & 31;
                p0_transpose_item(args.in[25] + (size_t)e * DE * DM, DM, 64 * kb, 32 * nb, WDN, DE, 64 * kb, e * DM + 32 * nb, scr, lane); }
        }
        if (BOTH(5)) xcd_barrier(bar);
    }
    if (IN(6)) { LANE_TID
        pg8::Gemm g{MERGED, WOUT, M, DM, DM, nullptr, nullptr}; pg8::StaticOrder S; S.init(M, DM, G, (int)blockIdx.x);
        pg8::EpiResid E{args.in[0], X1};
        pg8::gemm_phase<pg8::EpiResid, pg8::StaticOrder, true, true, false>(L + RING_OFF, g, S, E, wave);
        if (BOTH(6)) xcd_barrier(bar);
    }
    if (IN(7)) { LANE_TID
        LAS float* Wl = (LAS float*)L;
        for (int idx = tid; idx < DM * NG; idx += NWAVES * 64) Wl[(idx & 3) * DM + (idx >> 2)] = args.in[19][idx];
        for (int idx = tid; idx < DM * NE; idx += NWAVES * 64) Wl[(NG + (idx & 31)) * DM + (idx >> 5)] = args.in[21][idx];
        LAS int* s_hist = (LAS int*)(L + SCR_OFF); LAS int* s_base = s_hist + 32; LAS int* s_e = s_base + 32; LAS int* s_rank = s_e + 128; LAS float* s_g = (LAS float*)(s_rank + 128);
        const float* gam = args.in[18];
        for (int tb = vcu; tb < M / 64; tb += G) {
            if (tid < 32) s_hist[tid] = 0;
            __syncthreads();
#pragma unroll 1
            for (int pair = 0; pair < 4; ++pair) {
                const int tl = wave * 8 + pair * 2; const int m0 = tb * 64 + tl;
                f32x4 h0[4], h1[4]; float s0 = 0.f, s1 = 0.f;
#pragma unroll
                for (int j = 0; j < 4; ++j) { h0[j] = ((const GAS f32x4*)(X1 + (size_t)m0 * DM))[lane + 64 * j]; h1[j] = ((const GAS f32x4*)(X1 + (size_t)(m0 + 1) * DM))[lane + 64 * j];
                    s0 += (h0[j].x * h0[j].x + h0[j].y * h0[j].y) + (h0[j].z * h0[j].z + h0[j].w * h0[j].w); s1 += (h1[j].x * h1[j].x + h1[j].y * h1[j].y) + (h1[j].z * h1[j].z + h1[j].w * h1[j].w); }
                const float r0 = rsqrtf(wave_sum(s0) * (1.f / DM) + 1e-6f), r1 = rsqrtf(wave_sum(s1) * (1.f / DM) + 1e-6f);
#pragma unroll
                for (int j = 0; j < 4; ++j) { const f32x4 gg = ((const GAS f32x4*)gam)[lane + 64 * j]; h0[j] = h0[j] * gg * r0; h1[j] = h1[j] * gg * r1;
                    ((GAS unsigned long long*)(H2 + (size_t)m0 * DM))[lane + 64 * j] = (unsigned long long)pk2(h0[j].x, h0[j].y) | ((unsigned long long)pk2(h0[j].z, h0[j].w) << 32);
                    ((GAS unsigned long long*)(H2 + (size_t)(m0 + 1) * DM))[lane + 64 * j] = (unsigned long long)pk2(h1[j].x, h1[j].y) | ((unsigned long long)pk2(h1[j].z, h1[j].w) << 32); }
                LAS float* s_log = (LAS float*)(L + SCR_OFF + 2048) + wave * 80;
#pragma unroll 2
                for (int e = 0; e < NG + NE; ++e) { float t0 = 0.f, t1 = 0.f;
#pragma unroll
                    for (int j = 0; j < 4; ++j) { const f32x4 w = *(const LAS f32x4*)(Wl + e * DM + 4 * (lane + 64 * j));
                        t0 += (h0[j].x * w.x + h0[j].y * w.y) + (h0[j].z * w.z + h0[j].w * w.w); t1 += (h1[j].x * w.x + h1[j].y * w.y) + (h1[j].z * w.z + h1[j].w * w.w); }
                    t0 = wave_sum(t0); t1 = wave_sum(t1);
                    if (lane == 0) { s_log[e] = t0; s_log[40 + e] = t1; } }
                if (lane < 2) {
                    const LAS float* lp = s_log + lane * 40;
                    int gi = 0; float gm = lp[0] + args.in[20][0];
                    float lgv[NG]; lgv[0] = gm;
#pragma unroll
                    for (int e = 1; e < NG; ++e) { lgv[e] = lp[e] + args.in[20][e]; if (lgv[e] > gm) { gm = lgv[e]; gi = e; } }
                    float gs = 0.f;
#pragma unroll
                    for (int e = 0; e < NG; ++e) gs += expf(lgv[e] - gm);
                    const float gprob = 1.f / gs;
                    int i1 = 0, i2 = 0; float m1 = -INFINITY, m2 = -INFINITY;
#pragma unroll 1
                    for (int e = 0; e < EPG; ++e) { const float v = lp[NG + gi * EPG + e] + args.in[22][gi * EPG + e];
                        if (v > m1) { m2 = m1; i2 = i1; m1 = v; i1 = e; } else if (v > m2) { m2 = v; i2 = e; } }
                    const float ex = expf(m2 - m1);
                    const float p1 = gprob / (1.f + ex), p2 = gprob * ex / (1.f + ex);
                    const int e1 = gi * EPG + i1, e2 = gi * EPG + i2;
                    const int sl = (tl + lane) * 2;
                    s_e[sl] = e1; s_g[sl] = p1; s_rank[sl] = atomicAdd((int*)&s_hist[e1], 1);
                    s_e[sl + 1] = e2; s_g[sl + 1] = p2; s_rank[sl + 1] = atomicAdd((int*)&s_hist[e2], 1);
                }
            }
            __syncthreads();
            if (tid < 32) s_base[tid] = atomicAdd(&cnt[tid], s_hist[tid]);
            __syncthreads();
            if (tid < 128) { const int e = s_e[tid], pos = s_base[e] + s_rank[tid];
                elist[e * ECAP + pos] = (tb * 64 + (tid >> 1)) * 2 + (tid & 1); egate[e * ECAP + pos] = s_g[tid]; }
            __syncthreads();
        }
        if (BOTH(7)) xcd_barrier(bar);
    }
    if (IN(8) || IN(9)) { LANE_TID
        LAS int* seg = (LAS int*)(L + SCR_OFF);
        if (tid == 0) { int a = 0; for (int e = 0; e < NE; ++e) { seg[e] = a; a += (cnt[e] + 255) & ~255; } seg[NE] = a; }
        __syncthreads();
        if (IN(8)) {
            pg8::Gemm g{H2, WUP, MPAD, 2 * DE, DM, elist, cnt}; pg8::GroupOrder S{(const PG8_LAS int*)seg, 2, G, (int)blockIdx.x};
            pg8::EpiUp E{egate, cnt, ACT};
            pg8::gemm_phase<pg8::EpiUp, pg8::GroupOrder, true, true, true>(L + RING_OFF, g, S, E, wave);
            if (BOTH(8)) xcd_barrier(bar);
        }
        if (IN(9)) {
            pg8::Gemm g{ACT, WDN, MPAD, DM, DE, nullptr, nullptr}; pg8::GroupOrder S{(const PG8_LAS int*)seg, 4, G, (int)blockIdx.x};
            pg8::EpiDown E{elist, cnt, Y0, Y1};
            pg8::gemm_phase<pg8::EpiDown, pg8::GroupOrder, true, true, false>(L + RING_OFF, g, S, E, wave);
            if (BOTH(9)) xcd_barrier(bar);
        }
    }
    if (IN(10)) { LANE_TID
        const float* gam = args.in[26];
        for (int m = gw; m < M; m += NGW) {
            f32x4 v[4]; float s = 0.f;
#pragma unroll
            for (int j = 0; j < 4; ++j) { v[j] = ((const GAS f32x4*)(X1 + (size_t)m * DM))[lane + 64 * j];
                const unsigned long long a = ((const GAS unsigned long long*)(Y0 + (size_t)m * DM))[lane + 64 * j], b = ((const GAS unsigned long long*)(Y1 + (size_t)m * DM))[lane + 64 * j];
                v[j].x += __uint_as_float((unsigned)a << 16) + __uint_as_float((unsigned)b << 16);
                v[j].y += __uint_as_float((unsigned)a & 0xffff0000u) + __uint_as_float((unsigned)b & 0xffff0000u);
                v[j].z += __uint_as_float((unsigned)(a >> 32) << 16) + __uint_as_float((unsigned)(b >> 32) << 16);
                v[j].w += __uint_as_float((unsigned)(a >> 32) & 0xffff0000u) + __uint_as_float((unsigned)(b >> 32) & 0xffff0000u);
                s += (v[j].x * v[j].x + v[j].y * v[j].y) + (v[j].z * v[j].z + v[j].w * v[j].w); }
            const float rstd = rsqrtf(wave_sum(s) * (1.f / DM) + 1e-6f);
#pragma unroll
            for (int j = 0; j < 4; ++j) { const f32x4 gg = ((const GAS f32x4*)gam)[lane + 64 * j]; ((GAS f32x4*)(args.out + (size_t)m * DM))[lane + 64 * j] = v[j] * gg * rstd; }
        }
    }
#undef IN
#undef BOTH
#undef LANE_TID
}
typedef unsigned short bf16_t;

static int g_grid = 0;
static bool mk_setup() {
    if (g_grid != 0) return g_grid > 0;
    int dev = 0, cus = 0;
    if (hipGetDevice(&dev) != hipSuccess || hipDeviceGetAttribute(&cus, hipDeviceAttributeMultiprocessorCount, dev) != hipSuccess) { g_grid = -1; return false; }
    if (hipFuncSetAttribute((const void*)mk_fwd, hipFuncAttributeMaxDynamicSharedMemorySize, LDS_BYTES) != hipSuccess) { fprintf(stderr, "hipFuncSetAttribute failed\n"); g_grid = -1; return false; }
    int per_cu = 0;
    if (hipOccupancyMaxActiveBlocksPerMultiprocessor(&per_cu, (const void*)mk_fwd, NWAVES * 64, LDS_BYTES) != hipSuccess || per_cu < 1) { fprintf(stderr, "occupancy query: %d\n", per_cu); }
    (void)hipGetLastError();
    g_grid = cus;
    return true;
}
static void mk_launch(const Args& base, int lo, int hi, hipStream_t stream) {
    Args a = base; a.ph_lo = lo; a.ph_hi = hi; a.nbar = (hi - lo > 1) ? 1 : 0; a.pad = 0;
    hipLaunchKernelGGL(mk_fwd, dim3(g_grid), dim3(NWAVES * 64), LDS_BYTES, stream, a);
}

extern "C" void kernel_launch(void* const* d_in, const int* in_sizes, int n_in, void* d_out, int out_size, void* d_ws, size_t ws_size, hipStream_t stream) {
    const float* relb = (const float*)d_in[3];
    const float* mu = (const float*)d_in[4]; const float* w0 = (const float*)d_in[5]; const float* w2 = (const float*)d_in[6]; const float* a0 = (const float*)d_in[7];
    const float* a2 = (const float*)d_in[8]; const float* g2 = (const float*)d_in[9]; const float* k_k = (const float*)d_in[10]; const float* k_a = (const float*)d_in[11];
    const float* r_k = (const float*)d_in[12]; const float* gn_g = (const float*)d_in[13]; const float* gn_b = (const float*)d_in[14];
    unsigned char* ws = (unsigned char*)d_ws;
    if (ws_size < 256 * MiB || n_in != 27) { fprintf(stderr, "bad ws/n_in: %zu %d\n", ws_size, n_in); return; }
    if (!mk_setup()) return;
    bf16_t* BR = (bf16_t*)(ws + WS_BR); bf16_t* QKV = (bf16_t*)(ws + WS_QKV); bf16_t* RW = (bf16_t*)(ws + WS_RW);
    Args base{}; for (int i = 0; i < 27; ++i) base.in[i] = (const float*)d_in[i]; base.out = (float*)d_out; base.ws = ws;

    (void)hipMemsetAsync(ws + WS_CTL, 0, CTL_ZERO_BYTES, stream);
    mk_launch(base, 0, 11, stream);
}
```
